# Optimizing an MI355X kernel written in HIP

```python
import jax
import jax.numpy as jnp
from jax import lax
import numpy as np

D_MODEL = 1024
BATCH = 16
SEQ = 256
DEPTH = 2
DEC_BATCH = 4
DEC_SEQ = 1024
PAST_LEN = 512

GRID_W = 64
EPS = 1e-6
ROPE_THETA = 10000.0
Q_BLOCK = 128
N_BRANCH = 4
BRANCH_W = 512

HG_HEADS = 4
HG_DK = 128
HG_DV = 128
HG_CHUNK = 16

GQ_HEADS = 8
GQ_KV_HEADS = 2
GQ_HD = 64

NA_HEADS = 8
NA_HD = 64
NA_WIN_R = 8
NA_WIN_C = 16

ML_HEADS = 8
ML_NOPE = 64
ML_ROPE = 32
ML_V = 64
ML_Q_RANK = 256
ML_KV_RANK = 128

FFN_HIDDEN = -(-(8 * D_MODEL) // (3 * 256)) * 256

GQ_SCALE = GQ_HD ** -0.5
NA_SCALE = NA_HD ** -0.5
ML_SCALE = (ML_NOPE + ML_ROPE) ** -0.5

IN_SPLITS = (
    HG_HEADS * HG_DK,
    HG_HEADS * HG_DK,
    HG_HEADS * HG_DK,
    HG_HEADS * HG_DV,
    HG_HEADS * HG_DV,
    GQ_HEADS * GQ_HD,
    GQ_KV_HEADS * GQ_HD,
    GQ_KV_HEADS * GQ_HD,
    NA_HEADS * NA_HD,
    NA_HEADS * NA_HD,
    NA_HEADS * NA_HD,
    ML_Q_RANK,
    ML_KV_RANK,
    ML_ROPE,
    N_BRANCH * D_MODEL,
)
IN_WIDTH = sum(IN_SPLITS)

kernel_name = 'hybrid_diffusion_prefix_trunk_step'


def rms_norm(x, gain=None):
    xf = x.astype(jnp.float32)
    y = xf * lax.rsqrt(jnp.mean(xf * xf, axis=-1, keepdims=True) + EPS)
    if gain is not None:
        y = y * gain.astype(jnp.float32)
    return y.astype(x.dtype)


def adaln(cond, w_ada, b_ada):
    m = jax.nn.silu(cond) @ w_ada + b_ada
    return [t[:, None, :] for t in jnp.split(m, 6, axis=-1)]


def axial_rope(n_tokens, rot_dim):
    n_freq = rot_dim // 4
    inv_freq = ROPE_THETA ** (-jnp.arange(n_freq, dtype=jnp.float32) / n_freq)
    t = jnp.arange(n_tokens)
    row = (t // GRID_W).astype(jnp.float32)[:, None]
    col = (t % GRID_W).astype(jnp.float32)[:, None]
    ang = jnp.concatenate([row * inv_freq, col * inv_freq], axis=-1)
    return jnp.cos(ang), jnp.sin(ang)


def apply_rope(x, cos, sin):
    xf = x.astype(jnp.float32).reshape(x.shape[:-1] + (x.shape[-1] // 2, 2))
    x1, x2 = xf[..., 0], xf[..., 1]
    c, s = cos[:, None, :], sin[:, None, :]
    return jnp.stack([x1 * c - x2 * s, x1 * s + x2 * c], axis=-1).reshape(x.shape).astype(x.dtype)


def blocked_attention(q, k, v, scale):
    B, Tq, H, dk = q.shape
    kvh = k.shape[2]
    g = H // kvh
    nb = Tq // Q_BLOCK
    qb = jnp.moveaxis(q.reshape(B, nb, Q_BLOCK, kvh, g, dk), 1, 0)

    def block(qblk):
        s = jnp.einsum('bqngd,bknd->bngqk', qblk, k).astype(jnp.float32) * scale
        p = jax.nn.softmax(s, axis=-1).astype(v.dtype)
        return jnp.einsum('bngqk,bknd->bqngd', p, v)

    o = lax.map(block, qb)
    return jnp.moveaxis(o, 0, 1).reshape(B, Tq, H, v.shape[-1])


def chunk_gla(q, k, v, log_f, s0):
    B, T, H, DK = q.shape
    DV = v.shape[-1]
    C = HG_CHUNK
    n = T // C

    def chunks(a):
        return a.astype(jnp.float32).reshape(B, n, C, H, a.shape[-1]).transpose(1, 0, 3, 2, 4)

    qc, kc, vc, gc = chunks(q), chunks(k), chunks(v), chunks(log_f)
    b = jnp.cumsum(gc, axis=-2)
    causal = jnp.tril(jnp.ones((C, C), dtype=bool))
    diff = b[..., :, None, :] - b[..., None, :, :]
    decay = jnp.where(causal[:, :, None], jnp.exp(jnp.minimum(diff, 0.0)), 0.0)
    a_intra = jnp.einsum('nbhtd,nbhtsd,nbhsd->nbhts', qc, decay, kc)
    o_intra = jnp.einsum('nbhts,nbhsv->nbhtv', a_intra, vc)
    b_last = b[..., -1:, :]
    k_to_end = kc * jnp.exp(b_last - b)
    q_from_start = qc * jnp.exp(b)
    chunk_decay = jnp.exp(b_last[..., 0, :])

    def step(S, inp):
        qs, kend, vv, dec = inp
        o_inter = jnp.einsum('bhtk,bhkv->bhtv', qs, S)
        S_new = dec[..., None] * S + jnp.einsum('bhtk,bhtv->bhkv', kend, vv)
        return S_new, o_inter

    s_final, o_inter = lax.scan(step, s0.astype(jnp.float32), (q_from_start, k_to_end, vc, chunk_decay))
    o = (o_intra + o_inter).transpose(1, 0, 3, 2, 4).reshape(B, T, H, DV)
    return o, s_final


def hgrn_mixer(hq, hff, hfb, hi, hg, lb_f, lb_b, gain, s0_f, s0_b):
    B, T, _ = hq.shape

    def heads(a):
        return a.reshape(B, T, HG_HEADS, -1)

    q = heads(hq.astype(jnp.float32)) * (HG_DK ** -0.5)
    v = heads(hi.astype(jnp.float32))

    def forget(pre, lb):
        f = lb + (1.0 - lb) * jax.nn.sigmoid(pre.astype(jnp.float32))
        return heads(1.0 - f), heads(jnp.log(f))

    k_f, lf_f = forget(hff, lb_f)
    k_b, lf_b = forget(hfb, lb_b)
    o_f, s_f = chunk_gla(q, k_f, v, lf_f, s0_f)

    def rev(a):
        return jnp.flip(a, axis=1)

    o_b, s_b = chunk_gla(rev(q), rev(k_b), rev(v), rev(lf_b), s0_b)
    o = rms_norm(o_f + rev(o_b), gain) * jax.nn.silu(heads(hg.astype(jnp.float32)))
    return o.reshape(B, T, HG_HEADS * HG_DV), s_f, s_b


def neighbourhood_attention(q, k, v, k_ctx, v_ctx, rpb):
    B, T, H, d = q.shape
    rows = T // GRID_W
    wr = min(NA_WIN_R, rows)
    r = jnp.arange(rows)
    key_rows = jnp.clip(r - wr // 2, 0, rows - wr)[:, None] + jnp.arange(wr)[None, :]
    col = jnp.arange(GRID_W)
    col_start = jnp.clip(col - NA_WIN_C // 2, 0, GRID_W - NA_WIN_C)
    col_ok = (col[None, :] >= col_start[:, None]) & (col[None, :] < col_start[:, None] + NA_WIN_C)
    qg = q.reshape(B, rows, GRID_W, H, d)
    kg = k.reshape(B, rows, GRID_W, H, d)[:, key_rows]
    vg = v.reshape(B, rows, GRID_W, H, d)[:, key_rows]
    s_loc = jnp.einsum('brqhd,brjkhd->bhrqjk', qg, kg).astype(jnp.float32) * NA_SCALE
    dr_idx = key_rows - r[:, None] + NA_WIN_R - 1
    dc_idx = jnp.clip(col[None, :] - col[:, None] + NA_WIN_C - 1, 0, 2 * NA_WIN_C - 2)
    bias = rpb.astype(jnp.float32)[:, dr_idx[:, None, :, None], dc_idx[None, :, None, :]]
    s_loc = jnp.where(col_ok[:, None, :], s_loc + bias, -jnp.inf)
    n_loc = wr * GRID_W
    s_ctx = jnp.einsum('brqhd,bphd->bhrqp', qg, k_ctx).astype(jnp.float32) * NA_SCALE
    s = jnp.concatenate([s_loc.reshape(B, H, rows, GRID_W, n_loc), s_ctx], axis=-1)
    prob = jax.nn.softmax(s, axis=-1).astype(v.dtype)
    p_loc = prob[..., :n_loc].reshape(B, H, rows, GRID_W, wr, GRID_W)
    o = (jnp.einsum('bhrqjk,brjkhd->brqhd', p_loc, vg)
         + jnp.einsum('bhrqp,bphd->brqhd', prob[..., n_loc:], v_ctx))
    return o.reshape(B, T, H, d)


def mla_keys(ckv, k_rope, w_kv_b):
    B, T, _ = ckv.shape
    kv = (ckv @ w_kv_b).reshape(B, T, ML_HEADS, ML_NOPE + ML_V)
    k = jnp.concatenate([kv[..., :ML_NOPE],
                         jnp.broadcast_to(k_rope[:, :, None, :], (B, T, ML_HEADS, ML_ROPE))], axis=-1)
    return k, kv[..., ML_NOPE:]


def merge_branches(branches, gates, w_branch, w_out):
    B, T, _ = gates.shape
    o = jnp.stack(branches, axis=2)
    bo = jnp.einsum('btnc,ncd->btnd', o, w_branch)
    g = jax.nn.sigmoid(gates.astype(jnp.float32)).reshape(B, T, N_BRANCH, D_MODEL)
    merged = jnp.sum(g * bo.astype(jnp.float32), axis=2).astype(gates.dtype)
    return merged @ w_out


def trunk_layer(x, mod, p, ctx=None):
    B, T, _ = x.shape
    sh1, sc1, g1, sh2, sc2, g2 = mod
    h = rms_norm(x) * (1 + sc1) + sh1
    split_at = np.cumsum(IN_SPLITS)[:-1].tolist()
    (hq, hff, hfb, hi, hg, gq, gk, gv, nq, nk, nv, mqa, mkva, mkr, gates) = jnp.split(h @ p['w_in'], split_at, axis=-1)
    latent = ctx is not None

    if latent:
        s0_f, s0_b = ctx['hg'][:, 0], ctx['hg'][:, 1]
    else:
        s0_f = jnp.zeros((B, HG_HEADS, HG_DK, HG_DV), jnp.float32)
        s0_b = s0_f
    out_a, s_f, s_b = hgrn_mixer(hq, hff, hfb, hi, hg, p['lb_f'], p['lb_b'], p['hg_gain'], s0_f, s0_b)

    q_b = rms_norm(gq.reshape(B, T, GQ_HEADS, GQ_HD), p['gq_q_gain'])
    k_b = rms_norm(gk.reshape(B, T, GQ_KV_HEADS, GQ_HD), p['gq_k_gain'])
    v_b = gv.reshape(B, T, GQ_KV_HEADS, GQ_HD)
    q_c = nq.reshape(B, T, NA_HEADS, NA_HD)
    k_c = nk.reshape(B, T, NA_HEADS, NA_HD)
    v_c = nv.reshape(B, T, NA_HEADS, NA_HD)
    q_d = (rms_norm(mqa, p['ml_q_a_gain']) @ p['ml_w_q_b']).reshape(B, T, ML_HEADS, ML_NOPE + ML_ROPE)
    ckv = rms_norm(mkva, p['ml_kv_a_gain'])

    if latent:
        cos_b, sin_b = axial_rope(T, GQ_HD)
        cos_d, sin_d = axial_rope(T, ML_ROPE)
        q_b = apply_rope(q_b, cos_b, sin_b)
        k_b = apply_rope(k_b, cos_b, sin_b)
        out_b = blocked_attention(q_b, jnp.concatenate([ctx['gq_k'], k_b], axis=1),
                                  jnp.concatenate([ctx['gq_v'], v_b], axis=1), GQ_SCALE)
        out_c = neighbourhood_attention(q_c, k_c, v_c, ctx['na_k'], ctx['na_v'], p['na_rpb'])
        q_d = jnp.concatenate([q_d[..., :ML_NOPE], apply_rope(q_d[..., ML_NOPE:], cos_d, sin_d)], axis=-1)
        kr = apply_rope(mkr[:, :, None, :], cos_d, sin_d)[:, :, 0]
        k_lat, v_lat = mla_keys(ckv, kr, p['ml_w_kv_b'])
        k_ctx, v_ctx = mla_keys(ctx['ml_ckv'], ctx['ml_kr'], p['ml_w_kv_b'])
        out_d = blocked_attention(q_d, jnp.concatenate([k_ctx, k_lat], axis=1),
                                  jnp.concatenate([v_ctx, v_lat], axis=1), ML_SCALE)
        new = None
    else:
        out_b = blocked_attention(q_b, k_b, v_b, GQ_SCALE)
        out_c = blocked_attention(q_c, k_c, v_c, NA_SCALE)
        k_d, v_d = mla_keys(ckv, mkr, p['ml_w_kv_b'])
        out_d = blocked_attention(q_d, k_d, v_d, ML_SCALE)
        new = (jnp.stack([s_f, s_b], axis=1), k_b, v_b, k_c, v_c, ckv, mkr)

    branches = [o.reshape(B, T, BRANCH_W).astype(x.dtype) for o in (out_a, out_b, out_c, out_d)]
    x = x + g1 * merge_branches(branches, gates, p['w_branch'], p['w_out'])
    h2 = rms_norm(x) * (1 + sc2) + sh2
    a, gate_ffn = jnp.split(h2 @ p['w_ffn_in'], 2, axis=-1)
    x = x + g2 * ((jax.nn.silu(gate_ffn) * a) @ p['w_ffn_out'])
    return x, new


def setup_inputs(seed: int = 0) -> dict:
    key = jax.random.key(seed)
    ks = jax.random.split(key, 32)

    def nrm(k, shape, scale):
        return jax.random.normal(k, shape, jnp.float32) * scale

    D = D_MODEL
    P = PAST_LEN
    return {
        'x_prompt': nrm(ks[0], (BATCH, SEQ, D), 1.0),
        'x_sample': nrm(ks[1], (DEC_BATCH, DEC_SEQ, D), 1.0),
        'state_hgrn': nrm(ks[2], (DEC_BATCH, DEPTH, 2, HG_HEADS, HG_DK, HG_DV), 0.5),
        'cache_gqa_k': nrm(ks[3], (DEC_BATCH, DEPTH, P, GQ_KV_HEADS, GQ_HD), 1.0),
        'cache_gqa_v': nrm(ks[4], (DEC_BATCH, DEPTH, P, GQ_KV_HEADS, GQ_HD), 1.0),
        'cache_na_k': nrm(ks[5], (DEC_BATCH, DEPTH, P, NA_HEADS, NA_HD), 1.0),
        'cache_na_v': nrm(ks[6], (DEC_BATCH, DEPTH, P, NA_HEADS, NA_HD), 1.0),
        'cache_mla_ckv': nrm(ks[7], (DEC_BATCH, DEPTH, P, ML_KV_RANK), 1.0),
        'cache_mla_krope': nrm(ks[8], (DEC_BATCH, DEPTH, P, ML_ROPE), 1.0),
        'c': nrm(ks[9], (DEC_BATCH, D), 1.0),
        'c_ctx': nrm(ks[10], (D,), 1.0),
        'w_ada': nrm(ks[11], (DEPTH, D, 6 * D), 0.5 * D ** -0.5),
        'b_ada': nrm(ks[12], (DEPTH, 6 * D), 0.01),
        'w_in': nrm(ks[13], (DEPTH, D, IN_WIDTH), D ** -0.5),
        'hg_lb_logits': nrm(ks[14], (DEPTH, 2, HG_HEADS * HG_DK), 1.0),
        'hg_gain': 1.0 + nrm(ks[15], (DEPTH, HG_DV), 0.05),
        'gq_q_gain': 1.0 + nrm(ks[16], (DEPTH, GQ_HD), 0.05),
        'gq_k_gain': 1.0 + nrm(ks[17], (DEPTH, GQ_HD), 0.05),
        'na_rpb': nrm(ks[18], (DEPTH, NA_HEADS, 2 * NA_WIN_R - 1, 2 * NA_WIN_C - 1), 0.5),
        'ml_q_a_gain': 1.0 + nrm(ks[19], (DEPTH, ML_Q_RANK), 0.05),
        'ml_kv_a_gain': 1.0 + nrm(ks[20], (DEPTH, ML_KV_RANK), 0.05),
        'ml_w_q_b': nrm(ks[21], (DEPTH, ML_Q_RANK, ML_HEADS * (ML_NOPE + ML_ROPE)), ML_Q_RANK ** -0.5),
        'ml_w_kv_b': nrm(ks[22], (DEPTH, ML_KV_RANK, ML_HEADS * (ML_NOPE + ML_V)), ML_KV_RANK ** -0.5),
        'w_branch': nrm(ks[23], (DEPTH, N_BRANCH, BRANCH_W, D), BRANCH_W ** -0.5),
        'w_out': nrm(ks[24], (DEPTH, D, D), D ** -0.5),
        'w_ffn_in': nrm(ks[25], (DEPTH, D, 2 * FFN_HIDDEN), D ** -0.5),
        'w_ffn_out': nrm(ks[26], (DEPTH, FFN_HIDDEN, D), FFN_HIDDEN ** -0.5),
        'final_gain': 1.0 + nrm(ks[27], (D,), 0.05),
    }


def reference(x_prompt, x_sample, state_hgrn, cache_gqa_k, cache_gqa_v, cache_na_k, cache_na_v,
              cache_mla_ckv, cache_mla_krope, c, c_ctx, w_ada, b_ada, w_in, hg_lb_logits, hg_gain,
              gq_q_gain, gq_k_gain, na_rpb, ml_q_a_gain, ml_kv_a_gain, ml_w_q_b, ml_w_kv_b,
              w_branch, w_out, w_ffn_in, w_ffn_out, final_gain):
    lb = jnp.cumsum(jax.nn.softmax(hg_lb_logits.astype(jnp.float32), axis=0), axis=0)
    lb = lb - lb[:1]
    y_p, y_s = x_prompt, x_sample
    per_layer = []
    for l in range(DEPTH):
        p = {
            'w_in': w_in[l], 'lb_f': lb[l, 0], 'lb_b': lb[l, 1], 'hg_gain': hg_gain[l],
            'gq_q_gain': gq_q_gain[l], 'gq_k_gain': gq_k_gain[l], 'na_rpb': na_rpb[l],
            'ml_q_a_gain': ml_q_a_gain[l], 'ml_kv_a_gain': ml_kv_a_gain[l],
            'ml_w_q_b': ml_w_q_b[l], 'ml_w_kv_b': ml_w_kv_b[l],
            'w_branch': w_branch[l], 'w_out': w_out[l],
            'w_ffn_in': w_ffn_in[l], 'w_ffn_out': w_ffn_out[l],
        }
        y_p, new = trunk_layer(y_p, adaln(c_ctx[None, :], w_ada[l], b_ada[l]), p)
        per_layer.append(new)
        ctx = {
            'hg': state_hgrn[:, l], 'gq_k': cache_gqa_k[:, l], 'gq_v': cache_gqa_v[:, l],
            'na_k': cache_na_k[:, l], 'na_v': cache_na_v[:, l],
            'ml_ckv': cache_mla_ckv[:, l], 'ml_kr': cache_mla_krope[:, l],
        }
        y_s, _ = trunk_layer(y_s, adaln(c, w_ada[l], b_ada[l]), p, ctx)
    y_prompt = rms_norm(y_p, final_gain)
    y_sample = rms_norm(y_s, final_gain)
    new_state_hgrn = jnp.stack([n[0] for n in per_layer], axis=1)
    new_cache_gqa_k = jnp.stack([n[1] for n in per_layer], axis=1)
    new_cache_gqa_v = jnp.stack([n[2] for n in per_layer], axis=1)
    new_cache_na_k = jnp.stack([n[3] for n in per_layer], axis=1)
    new_cache_na_v = jnp.stack([n[4] for n in per_layer], axis=1)
    new_cache_mla_ckv = jnp.stack([n[5] for n in per_layer], axis=1)
    new_cache_mla_krope = jnp.stack([n[6] for n in per_layer], axis=1)
    return (y_prompt, y_sample, new_state_hgrn, new_cache_gqa_k, new_cache_gqa_v,
            new_cache_na_k, new_cache_na_v, new_cache_mla_ckv, new_cache_mla_krope)
```

```cpp
#include <hip/hip_runtime.h>
#include <hip/hip_cooperative_groups.h>
#include <stdint.h>
#include <cstdio>
namespace cg = cooperative_groups;

typedef unsigned short u16;
typedef __attribute__((ext_vector_type(8))) short bf16x8;
typedef __attribute__((ext_vector_type(4))) short bf16x4;
typedef __attribute__((ext_vector_type(16))) float f32x16;
typedef __attribute__((ext_vector_type(2))) float f32x2;
typedef __attribute__((ext_vector_type(4))) float f32v4;
typedef __attribute__((ext_vector_type(4))) unsigned u32x4;
typedef __attribute__((ext_vector_type(2))) __bf16 bfx2;
#define DI __device__ __forceinline__
#define MFMA32(a, b, c) __builtin_amdgcn_mfma_f32_32x32x16_bf16((a), (b), (c), 0, 0, 0)

constexpr int D = 1024;
constexpr int NTOK = 8192;
constexpr int NCTX = 4096;
constexpr int PW = 5280;
constexpr int INW = 9376;
constexpr int FFH = 2816;
constexpr int C_HQ = 0, C_HFF = 512, C_HFB = 1024, C_HI = 1536, C_HG = 2048, C_GQ = 2560, C_GK = 3072, C_GV = 3200,
              C_NQ = 3328, C_NK = 3840, C_NV = 4352, C_MQA = 4864, C_MKVA = 5120, C_MKR = 5248, C_GATES = 5280;
constexpr float EPS = 1e-6f;
constexpr float LOG2E = 1.4426950408889634f;

constexpr size_t O_X = 0;
constexpr size_t O_STATE = 8388608;
constexpr size_t O_GQK = 12582912;
constexpr size_t O_GQV = 13631488;
constexpr size_t O_NAK = 14680064;
constexpr size_t O_NAV = 18874368;
constexpr size_t O_CKV = 23068672;
constexpr size_t O_KR = 24117248;

constexpr size_t W_IN = 0;
constexpr size_t W_FFI = W_IN + (size_t)INW * 1024 * 2;
constexpr size_t W_FFO = W_FFI + (size_t)5632 * 1024 * 2;
constexpr size_t W_BR = W_FFO + (size_t)1024 * FFH * 2;
constexpr size_t W_OUT = W_BR + (size_t)4 * 1024 * 512 * 2;
constexpr size_t W_QB = W_OUT + (size_t)1024 * 1024 * 2;
constexpr size_t W_KVB = W_QB + (size_t)768 * 256 * 2;
constexpr size_t W_MOD = W_KVB + (size_t)1024 * 128 * 2;
constexpr size_t W_LBV = W_MOD + (size_t)2 * 5 * 6144 * 4;
constexpr size_t W_ROPEB = W_LBV + (size_t)2 * 2 * 512 * 4;
constexpr size_t W_ROPED = W_ROPEB + (size_t)1024 * 32 * 8;
constexpr size_t W_PROJ = W_ROPED + (size_t)1024 * 16 * 8;
constexpr size_t W_H = W_PROJ + (size_t)NTOK * PW * 2;
constexpr size_t W_BRANCH = W_H + (size_t)NTOK * 1024 * 2;
constexpr size_t W_OB = W_BRANCH + (size_t)NTOK * 2048 * 2;
constexpr size_t W_QBF = W_OB + (size_t)NTOK * 512 * 2;
constexpr size_t W_KBC = W_QBF + (size_t)NTOK * 512 * 2;
constexpr size_t W_KBL = W_KBC + (size_t)4096 * 128 * 2;
constexpr size_t W_VBTC = W_KBL + (size_t)4 * 1536 * 128 * 2;
constexpr size_t W_VBTL = W_VBTC + (size_t)16 * 128 * 256 * 2;
constexpr size_t W_NKC = W_VBTL + (size_t)4 * 128 * 1536 * 2;
constexpr size_t W_NVTC = W_NKC + (size_t)4 * 512 * 512 * 2;
constexpr size_t W_NVTL = W_NVTC + (size_t)16 * 512 * 256 * 2;
constexpr size_t W_AQ = W_NVTL + (size_t)4 * 512 * 1536 * 2;
constexpr size_t W_ACKV = W_AQ + (size_t)NTOK * 256 * 2;
constexpr size_t W_QD = W_ACKV + (size_t)10240 * 128 * 2;
constexpr size_t W_KDC = W_QD + (size_t)NTOK * 768 * 2;
constexpr size_t W_KDL = W_KDC + (size_t)4096 * 768 * 2;
constexpr size_t W_VDTC = W_KDL + (size_t)4 * 1536 * 768 * 2;
constexpr size_t W_VDTL = W_VDTC + (size_t)16 * 512 * 256 * 2;
constexpr size_t W_END = W_VDTL + (size_t)4 * 512 * 1536 * 2;
constexpr size_t W_CTR = W_END;
constexpr size_t W_BAR = W_END + 64;
constexpr size_t W_SET2 = W_BAR + 3456 * 4 + 64;
constexpr size_t W_TOTAL = W_SET2 + W_MOD;
constexpr size_t W_MERGED = W_OB;
constexpr size_t W_HIDDEN = W_PROJ;

constexpr int SMEM_HALF = 73728;
constexpr int SMEM_BYTES = 2 * SMEM_HALF;

struct Params {
  const float *x_prompt, *x_sample, *state_hgrn, *cgk, *cgv, *cnk, *cnv, *cckv, *ckr, *c, *c_ctx, *w_ada, *b_ada, *w_in,
      *lb_logits, *hg_gain, *gq_q_gain, *gq_k_gain, *na_rpb, *ml_q_a_gain, *ml_kv_a_gain, *ml_w_q_b, *ml_w_kv_b, *w_branch,
      *w_out, *w_ffn_in, *w_ffn_out, *final_gain;
  float* out;
  char* ws;
};

DI int tidx() { int t = threadIdx.x & 255; asm volatile("" : "+v"(t)); return t; }
DI int tidx512() { int t = threadIdx.x; asm volatile("" : "+v"(t)); return t; }
DI void launder_params(Params& q) { size_t z = 0; asm volatile("" : "+s"(z)); q.ws += z; q.out += z; }

DI float bf2f(u16 b) { return __uint_as_float(((unsigned)b) << 16); }
DI unsigned pk2(float a, float b) {
  f32x2 v = {a, b};
  bfx2 r = __builtin_convertvector(v, bfx2);
  return __builtin_bit_cast(unsigned, r);
}
DI u16 f2bf(float a) { return (u16)(pk2(a, 0.f) & 0xffffu); }
DI uint2 pk4(float a, float b, float c, float d) { uint2 r; r.x = pk2(a, b); r.y = pk2(c, d); return r; }
DI float frcp(float x) { return __builtin_amdgcn_rcpf(x); }
DI float sigmoidf_(float x) { return frcp(1.f + __expf(-x)); }
DI float siluf_(float x) { return x * frcp(1.f + __expf(-x)); }
DI void unpack4(uint2 u, float* f) {
  f[0] = __uint_as_float(u.x << 16); f[1] = __uint_as_float(u.x & 0xffff0000u);
  f[2] = __uint_as_float(u.y << 16); f[3] = __uint_as_float(u.y & 0xffff0000u);
}
DI void unpack8(uint4 u, float* f) {
  f[0] = __uint_as_float(u.x << 16); f[1] = __uint_as_float(u.x & 0xffff0000u);
  f[2] = __uint_as_float(u.y << 16); f[3] = __uint_as_float(u.y & 0xffff0000u);
  f[4] = __uint_as_float(u.z << 16); f[5] = __uint_as_float(u.z & 0xffff0000u);
  f[6] = __uint_as_float(u.w << 16); f[7] = __uint_as_float(u.w & 0xffff0000u);
}

DI float shx(float v, int m) {
  int iv = __float_as_int(v), r;
  switch (m) {
    case 1:  r = __builtin_amdgcn_ds_swizzle(iv, 0x041f); break;
    case 2:  r = __builtin_amdgcn_ds_swizzle(iv, 0x081f); break;
    case 4:  r = __builtin_amdgcn_ds_swizzle(iv, 0x101f); break;
    case 8:  r = __builtin_amdgcn_ds_swizzle(iv, 0x201f); break;
    case 16: r = __builtin_amdgcn_ds_swizzle(iv, 0x401f); break;
    default: {
      int lid = __builtin_amdgcn_mbcnt_hi(~0u, __builtin_amdgcn_mbcnt_lo(~0u, 0u));
      asm volatile("" : "+v"(lid));
      r = __builtin_amdgcn_ds_bpermute((lid ^ 32) << 2, iv);
    } break;
  }
  return __int_as_float(r);
}
DI float4 ldnt4(const float* p) { f32v4 t = __builtin_nontemporal_load((const f32v4*)p); return make_float4(t[0], t[1], t[2], t[3]); }
DI void stnt4(float* p, float4 v) { f32v4 t = {v.x, v.y, v.z, v.w}; __builtin_nontemporal_store(t, (f32v4*)p); }
DI int crow(int i, int g) { return (i & 3) + 8 * (i >> 2) + 4 * g; }
DI int cond_of_row(int row) { return row < NCTX ? 0 : 1 + ((row - NCTX) >> 10); }

template <int MB, int NB>
DI void gemm_core(const u16* __restrict__ A, int lda, const u16* __restrict__ B, int ldb, int nvalid, int K,
                  f32x16 (&acc)[MB][NB], char* smem) {
  constexpr int BM = 64 * MB, BN = 64 * NB;
  constexpr int LROW = 144;
  constexpr int ACH = MB * 2, BCH = NB * 2;
  char* As = smem;
  char* Bs = smem + 2 * BM * LROW;
  const int tid = tidx(), lane = tid & 63, wave = tid >> 6, wm = wave >> 1, wn = wave & 1;
  u32x4 ra0[ACH], rb0[BCH], ra1[ACH], rb1[BCH];
  const int crow_ = tid >> 3, ckc = tid & 7;
  const u16* ap[ACH];
  const u16* bp[BCH];
#pragma unroll
  for (int i = 0; i < ACH; ++i) ap[i] = A + (size_t)(crow_ + 32 * i) * lda + ckc * 8;
#pragma unroll
  for (int i = 0; i < BCH; ++i) {
    int r = crow_ + 32 * i;
    r = r < nvalid ? r : nvalid - 1;
    bp[i] = B + (size_t)r * ldb + ckc * 8;
  }
  int nk = K >> 6;
  asm volatile("" : "+s"(nk));
  char* const as_w = As + crow_ * LROW + ckc * 16;
  char* const bs_w = Bs + crow_ * LROW + ckc * 16;
  const char* const a_rd = As + (wm * 32 * MB + (lane & 31)) * LROW + (lane >> 5) * 16;
  const char* const b_rd = Bs + (wn * 32 * NB + (lane & 31)) * LROW + (lane >> 5) * 16;
#define GLOAD(RA, RB, K0)                                                               \
  {                                                                                     \
    _Pragma("unroll") for (int i = 0; i < ACH; ++i) RA[i] = *(const u32x4*)(ap[i] + (K0)); \
    _Pragma("unroll") for (int i = 0; i < BCH; ++i) RB[i] = *(const u32x4*)(bp[i] + (K0)); \
  }
#define SSTORE(RA, RB, BUF)                                                                              \
  {                                                                                                      \
    _Pragma("unroll") for (int i = 0; i < ACH; ++i) *(u32x4*)(as_w + ((BUF) * BM + 32 * i) * LROW) = RA[i]; \
    _Pragma("unroll") for (int i = 0; i < BCH; ++i) *(u32x4*)(bs_w + ((BUF) * BN + 32 * i) * LROW) = RB[i]; \
  }
#define COMPUTE(BUF)                                                                                  \
  {                                                                                                   \
    bf16x8 af[4][MB], bfr[4][NB];                                                                     \
    _Pragma("unroll") for (int s = 0; s < 4; ++s) {                                                   \
      _Pragma("unroll") for (int mb = 0; mb < MB; ++mb)                                               \
        af[s][mb] = *(const bf16x8*)(a_rd + ((BUF) * BM + mb * 32) * LROW + s * 32);                  \
      _Pragma("unroll") for (int nb = 0; nb < NB; ++nb)                                               \
        bfr[s][nb] = *(const bf16x8*)(b_rd + ((BUF) * BN + nb * 32) * LROW + s * 32);                 \
    }                                                                                                 \
    _Pragma("unroll") for (int s = 0; s < 4; ++s)                                                     \
      _Pragma("unroll") for (int mb = 0; mb < MB; ++mb)                                               \
        _Pragma("unroll") for (int nb = 0; nb < NB; ++nb)                                             \
          acc[mb][nb] = MFMA32(af[s][mb], bfr[s][nb], acc[mb][nb]);                                   \
  }
  GLOAD(ra0, rb0, 0)
  GLOAD(ra1, rb1, 64)
  SSTORE(ra0, rb0, 0)
  __syncthreads();
  for (int kt = 0; kt < nk; kt += 2) {
    const int t2 = (kt + 2 < nk) ? kt + 2 : nk - 2;
    GLOAD(ra0, rb0, t2 << 6)
    __builtin_amdgcn_sched_barrier(0);
    COMPUTE(0)
    SSTORE(ra1, rb1, 1)
    __syncthreads();
    GLOAD(ra1, rb1, (t2 + 1) << 6)
    __builtin_amdgcn_sched_barrier(0);
    COMPUTE(1)
    SSTORE(ra0, rb0, 0)
    __syncthreads();
  }
#undef GLOAD
#undef SSTORE
#undef COMPUTE
}

template <int MB, int NB>
DI void zero_acc(f32x16 (&acc)[MB][NB]) {
#pragma unroll
  for (int mb = 0; mb < MB; ++mb)
#pragma unroll
    for (int nb = 0; nb < NB; ++nb)
#pragma unroll
      for (int i = 0; i < 16; ++i) acc[mb][nb][i] = 0.f;
}

#define EPI_LOOP(MB, NB, acc, BODY)                                              \
  {                                                                              \
    const int lane_ = tidx() & 63, wave_ = tidx() >> 6;                \
    const int wm_ = wave_ >> 1, wn_ = wave_ & 1, g_ = lane_ >> 5;                \
    _Pragma("unroll") for (int mb = 0; mb < MB; ++mb)                            \
    _Pragma("unroll") for (int nb = 0; nb < NB; ++nb)                            \
    _Pragma("unroll") for (int q4 = 0; q4 < 4; ++q4) {                           \
      const int er = wm_ * 32 * MB + mb * 32 + 8 * q4 + 4 * g_;                  \
      const int ec = wn_ * 32 * NB + nb * 32 + (lane_ & 31);                     \
      const float v0 = acc[mb][nb][4 * q4 + 0], v1 = acc[mb][nb][4 * q4 + 1];    \
      const float v2 = acc[mb][nb][4 * q4 + 2], v3 = acc[mb][nb][4 * q4 + 3];    \
      BODY                                                                       \
    }                                                                            \
  }


template <int MB, int NB>
DI void gemm512_core(const u16* __restrict__ A, int lda, const u16* __restrict__ B, int ldb, int nvalid, int K,
                     f32x16 (&acc)[MB][NB], char* smem) {
  constexpr int BM = 128 * MB, BN = 64 * NB;
  constexpr int LROW = 144;
  constexpr int ACH = BM / 64, BCH = BN / 64;
  char* As = smem;
  char* Bs = smem + 2 * BM * LROW;
  const int tid = tidx512(), lane = tid & 63, wave = tid >> 6, wm = wave >> 1, wn = wave & 1;
  u32x4 ra[ACH], rb[BCH];
  const int crow_ = tid >> 3, ckc = tid & 7;
  const unsigned aoff = (unsigned)(crow_ * lda + ckc * 8) * 2u;
  unsigned boff[BCH];
#pragma unroll
  for (int i = 0; i < BCH; ++i) {
    int r = crow_ + 64 * i;
    r = r < nvalid ? r : nvalid - 1;
    boff[i] = (unsigned)(r * ldb + ckc * 8) * 2u;
  }
  const char* const Ab = (const char*)A;
  const char* const Bb = (const char*)B;
  const size_t astep = (size_t)64 * lda * 2;
  int nk = K >> 6;
  asm volatile("" : "+s"(nk));
  char* const as_w = As + crow_ * LROW + ckc * 16;
  char* const bs_w = Bs + crow_ * LROW + ckc * 16;
  const char* const a_rd = As + (wm * 32 * MB + (lane & 31)) * LROW + (lane >> 5) * 16;
  const char* const b_rd = Bs + (wn * 32 * NB + (lane & 31)) * LROW + (lane >> 5) * 16;
#define GLOAD5(K0)                                                                      \
  {                                                                                     \
    _Pragma("unroll") for (int i = 0; i < ACH; ++i) ra[i] = *(const u32x4*)(Ab + (size_t)i * astep + (size_t)(K0) * 2 + aoff); \
    _Pragma("unroll") for (int i = 0; i < BCH; ++i) rb[i] = *(const u32x4*)(Bb + (size_t)(K0) * 2 + boff[i]); \
  }
#define SSTORE5(BUF)                                                                                     \
  {                                                                                                      \
    _Pragma("unroll") for (int i = 0; i < ACH; ++i) *(u32x4*)(as_w + ((BUF) * BM + 64 * i) * LROW) = ra[i]; \
    _Pragma("unroll") for (int i = 0; i < BCH; ++i) *(u32x4*)(bs_w + ((BUF) * BN + 64 * i) * LROW) = rb[i]; \
  }
  GLOAD5(0)
  SSTORE5(0)
  GLOAD5(64)
  __syncthreads();
  for (int kt = 0; kt < nk; ++kt) {
    const int buf = kt & 1;
    const int t2 = (kt + 2 < nk) ? kt + 2 : nk - 1;
    const size_t k2 = (size_t)(t2 << 6) * 2;
#pragma unroll
    for (int s = 0; s < 4; ++s) {
      bf16x8 af[MB], bfr[NB];
#pragma unroll
      for (int mb = 0; mb < MB; ++mb) af[mb] = *(const bf16x8*)(a_rd + (buf * BM + mb * 32) * LROW + s * 32);
#pragma unroll
      for (int nb = 0; nb < NB; ++nb) bfr[nb] = *(const bf16x8*)(b_rd + (buf * BN + nb * 32) * LROW + s * 32);
      if (s < ACH) {
        *(u32x4*)(as_w + ((buf ^ 1) * BM + 64 * s) * LROW) = ra[s];
        ra[s] = *(const u32x4*)(Ab + (size_t)s * astep + k2 + aoff);
      }
      if (s < BCH) {
        *(u32x4*)(bs_w + ((buf ^ 1) * BN + 64 * s) * LROW) = rb[s];
        rb[s] = *(const u32x4*)(Bb + k2 + boff[s]);
      }
      __builtin_amdgcn_sched_barrier(0);
#pragma unroll
      for (int mb = 0; mb < MB; ++mb)
#pragma unroll
        for (int nb = 0; nb < NB; ++nb) acc[mb][nb] = MFMA32(af[mb], bfr[nb], acc[mb][nb]);
    }
    __syncthreads();
  }
#undef GLOAD5
#undef SSTORE5
}


template <int NB>
struct GDesc512 { const char* Ab; const char* Bb; size_t astep; unsigned aoff; unsigned boff[NB]; int nk; };

template <int NB>
DI GDesc512<NB> make_gdesc(const u16* A, int lda, const u16* B, int ldb, int nvalid, int K) {
  const int tid = tidx512();
  const int crow_ = tid >> 3, ckc = tid & 7;
  GDesc512<NB> d;
  d.Ab = (const char*)A; d.Bb = (const char*)B;
  d.astep = (size_t)64 * lda * 2;
  d.aoff = (unsigned)(crow_ * lda + ckc * 8) * 2u;
#pragma unroll
  for (int i = 0; i < NB; ++i) {
    int r = crow_ + 64 * i;
    r = r < nvalid ? r : nvalid - 1;
    d.boff[i] = (unsigned)(r * ldb + ckc * 8) * 2u;
  }
  d.nk = K >> 6;
  return d;
}

template <int MB, int NB>
DI void gemm512_chain(const GDesc512<NB>& c, const GDesc512<NB>& n, bool has_next, bool preloaded,
                      u32x4 (&ra)[2 * MB], u32x4 (&rb)[NB], f32x16 (&acc)[MB][NB], char* smem) {
  constexpr int BM = 128 * MB, BN = 64 * NB;
  constexpr int LROW = 144;
  constexpr int ACH = 2 * MB, BCH = NB;
  char* As = smem;
  char* Bs = smem + 2 * BM * LROW;
  const int tid = tidx512(), lane = tid & 63, wave = tid >> 6, wm = wave >> 1, wn = wave & 1;
  const int crow_ = tid >> 3, ckc = tid & 7;
  int nk = c.nk;
  asm volatile("" : "+s"(nk));
  char* const as_w = As + crow_ * LROW + ckc * 16;
  char* const bs_w = Bs + crow_ * LROW + ckc * 16;
  const char* const a_rd = As + (wm * 32 * MB + (lane & 31)) * LROW + (lane >> 5) * 16;
  const char* const b_rd = Bs + (wn * 32 * NB + (lane & 31)) * LROW + (lane >> 5) * 16;
  if (!preloaded) {
#pragma unroll
    for (int i = 0; i < ACH; ++i) ra[i] = *(const u32x4*)(c.Ab + (size_t)i * c.astep + c.aoff);
#pragma unroll
    for (int i = 0; i < BCH; ++i) rb[i] = *(const u32x4*)(c.Bb + c.boff[i]);
#pragma unroll
    for (int i = 0; i < ACH; ++i) *(u32x4*)(as_w + (64 * i) * LROW) = ra[i];
#pragma unroll
    for (int i = 0; i < BCH; ++i) *(u32x4*)(bs_w + (64 * i) * LROW) = rb[i];
#pragma unroll
    for (int i = 0; i < ACH; ++i) ra[i] = *(const u32x4*)(c.Ab + (size_t)i * c.astep + 128 + c.aoff);
#pragma unroll
    for (int i = 0; i < BCH; ++i) rb[i] = *(const u32x4*)(c.Bb + 128 + c.boff[i]);
    __syncthreads();
  }
#define CH_ITER(BUF, SAB, SASTEP, SAOFF, SBB, SBOFF, K2)                                                   \
  {                                                                                                        \
    _Pragma("unroll") for (int s = 0; s < 4; ++s) {                                                        \
      bf16x8 af[MB], bfr[NB];                                                                              \
      _Pragma("unroll") for (int mb = 0; mb < MB; ++mb)                                                    \
        af[mb] = *(const bf16x8*)(a_rd + ((BUF) * BM + mb * 32) * LROW + s * 32);                          \
      _Pragma("unroll") for (int nb = 0; nb < NB; ++nb)                                                    \
        bfr[nb] = *(const bf16x8*)(b_rd + ((BUF) * BN + nb * 32) * LROW + s * 32);                         \
      if (s < ACH) {                                                                                       \
        *(u32x4*)(as_w + (((BUF) ^ 1) * BM + 64 * s) * LROW) = ra[s];                                      \
        ra[s] = *(const u32x4*)((SAB) + (size_t)s * (SASTEP) + (K2) + (SAOFF));                            \
      }                                                                                                    \
      if (s < BCH) {                                                                                       \
        *(u32x4*)(bs_w + (((BUF) ^ 1) * BN + 64 * s) * LROW) = rb[s];                                      \
        rb[s] = *(const u32x4*)((SBB) + (K2) + (SBOFF)[s]);                                                \
      }                                                                                                    \
      __builtin_amdgcn_sched_barrier(0);                                                                   \
      _Pragma("unroll") for (int mb = 0; mb < MB; ++mb)                                                    \
        _Pragma("unroll") for (int nb = 0; nb < NB; ++nb) acc[mb][nb] = MFMA32(af[mb], bfr[nb], acc[mb][nb]); \
    }                                                                                                      \
    __syncthreads();                                                                                       \
  }
  for (int kt = 0; kt < nk - 2; ++kt) {
    const int buf = kt & 1;
    const size_t k2 = (size_t)(kt + 2) * 128;
    CH_ITER(buf, c.Ab, c.astep, c.aoff, c.Bb, c.boff, k2)
  }
  {
    const char* tAb = has_next ? n.Ab : c.Ab;
    const char* tBb = has_next ? n.Bb : c.Bb;
    const size_t tastep = has_next ? n.astep : c.astep;
    const unsigned taoff = has_next ? n.aoff : c.aoff;
    unsigned tboff[NB];
#pragma unroll
    for (int i = 0; i < NB; ++i) tboff[i] = has_next ? n.boff[i] : c.boff[i];
    const size_t k2a = has_next ? (size_t)0 : (size_t)(nk - 1) * 128;
    const size_t k2b = has_next ? (size_t)128 : (size_t)(nk - 1) * 128;
    CH_ITER(0, tAb, tastep, taoff, tBb, tboff, k2a)
    CH_ITER(1, tAb, tastep, taoff, tBb, tboff, k2b)
  }
#undef CH_ITER
}

#define EPI512(MB, NB, acc, BODY)                                                \
  {                                                                              \
    const int t5_ = tidx512();                                                   \
    const int lane_ = t5_ & 63, wave_ = t5_ >> 6;                                \
    const int wm_ = wave_ >> 1, wn_ = wave_ & 1, g_ = lane_ >> 5;                \
    _Pragma("unroll") for (int mb = 0; mb < MB; ++mb)                            \
    _Pragma("unroll") for (int nb = 0; nb < NB; ++nb)                            \
    _Pragma("unroll") for (int q4 = 0; q4 < 4; ++q4) {                           \
      const int er = wm_ * 32 * MB + mb * 32 + 8 * q4 + 4 * g_;                  \
      const int ec = wn_ * 32 * NB + nb * 32 + (lane_ & 31);                     \
      const float v0 = acc[mb][nb][4 * q4 + 0], v1 = acc[mb][nb][4 * q4 + 1];    \
      const float v2 = acc[mb][nb][4 * q4 + 2], v3 = acc[mb][nb][4 * q4 + 3];    \
      BODY                                                                       \
    }                                                                            \
  }

DI int ffn_perm(int n) {
  int j = n < FFH ? n : n - FFH;
  return (j >> 5) * 64 + (j & 31) + (n < FFH ? 0 : 32);
}
DI void wtrans_tile(const float* __restrict__ src, int K, int N, int kt, int nt4, u16* __restrict__ dst, bool perm, char* smem) {
  float(*s)[65] = (float(*)[65])smem;
  const int tid = tidx();
  const int k0 = kt * 64;
  float4 v[4][4];
#pragma unroll
  for (int q = 0; q < 4; ++q)
#pragma unroll
    for (int i = 0; i < 4; ++i) {
      int r = (tid >> 4) + 16 * i, c4 = tid & 15;
      int n = (nt4 * 4 + q) * 64 + c4 * 4;
      v[q][i] = make_float4(0.f, 0.f, 0.f, 0.f);
      if (n < N) v[q][i] = ldnt4(src + (size_t)(k0 + r) * N + n);
    }
#pragma unroll
  for (int q = 0; q < 4; ++q) {
    const int n0 = (nt4 * 4 + q) * 64;
#pragma unroll
    for (int i = 0; i < 4; ++i) {
      int r = (tid >> 4) + 16 * i, c4 = tid & 15;
      s[r][c4 * 4 + 0] = v[q][i].x; s[r][c4 * 4 + 1] = v[q][i].y; s[r][c4 * 4 + 2] = v[q][i].z; s[r][c4 * 4 + 3] = v[q][i].w;
    }
    __syncthreads();
#pragma unroll
    for (int j = 0; j < 2; ++j) {
      int ch = tid + 256 * j;
      int n = ch >> 3, kc = ch & 7;
      if (n0 + n < N) {
        int dn = perm ? ffn_perm(n0 + n) : (n0 + n);
        uint4 o;
        o.x = pk2(s[kc * 8 + 0][n], s[kc * 8 + 1][n]);
        o.y = pk2(s[kc * 8 + 2][n], s[kc * 8 + 3][n]);
        o.z = pk2(s[kc * 8 + 4][n], s[kc * 8 + 5][n]);
        o.w = pk2(s[kc * 8 + 6][n], s[kc * 8 + 7][n]);
        *(uint4*)(dst + (size_t)dn * K + k0 + kc * 8) = o;
      }
    }
    __syncthreads();
  }
}

template <bool F32SRC>
DI void tr32x128(const void* src, size_t sstride, u16* dst, size_t dstride, char* smem) {
  u16(*s)[136] = (u16(*)[136])smem;
  const int tid = tidx();
  const int r = tid >> 3, c16 = (tid & 7) * 16;
  if (F32SRC) {
    const float* sp = (const float*)src + (size_t)r * sstride + c16;
#pragma unroll
    for (int i = 0; i < 4; ++i) {
      float4 v = ldnt4(sp + 4 * i);
      *(uint2*)(&s[r][c16 + 4 * i]) = pk4(v.x, v.y, v.z, v.w);
    }
  } else {
    const u16* sp = (const u16*)src + (size_t)r * sstride + c16;
    uint4 a = *(const uint4*)(sp), b = *(const uint4*)(sp + 8);
    *(uint4*)(&s[r][c16]) = a;
    *(uint4*)(&s[r][c16 + 8]) = b;
  }
  __syncthreads();
#pragma unroll
  for (int j = 0; j < 2; ++j) {
    int ch = tid + 256 * j;
    int col = ch >> 2, kc = ch & 3;
    uint4 o;
    o.x = (unsigned)s[kc * 8 + 0][col] | ((unsigned)s[kc * 8 + 1][col] << 16);
    o.y = (unsigned)s[kc * 8 + 2][col] | ((unsigned)s[kc * 8 + 3][col] << 16);
    o.z = (unsigned)s[kc * 8 + 4][col] | ((unsigned)s[kc * 8 + 5][col] << 16);
    o.w = (unsigned)s[kc * 8 + 6][col] | ((unsigned)s[kc * 8 + 7][col] << 16);
    *(uint4*)(dst + (size_t)col * dstride + kc * 8) = o;
  }
  __syncthreads();
}

DI void adaln_job(const Params& p_in, int l, int jg, char* smem) {
  Params p = p_in; launder_params(p);
  float* sc = (float*)smem;
  float* red = sc + 5 * 1024;
  const int tid = tidx(), lane = tid & 63, wave = tid >> 6;
  for (int idx = tid; idx < 5 * 1024; idx += 256) {
    int c = idx >> 10, k = idx & 1023;
    float v = (c == 0) ? p.c_ctx[k] : p.c[(c - 1) * 1024 + k];
    sc[idx] = siluf_(v);
  }
  __syncthreads();
  const int j = jg * 64 + lane;
  float acc[5] = {0.f, 0.f, 0.f, 0.f, 0.f};
  const float* wp = p.w_ada + ((size_t)l * 1024 + wave * 256) * 6144 + j;
  const float* sp = sc + wave * 256;
#pragma unroll 64
  for (int k = 0; k < 256; ++k) {
    float wv = __builtin_nontemporal_load(wp + (size_t)k * 6144);
#pragma unroll
    for (int c = 0; c < 5; ++c) acc[c] += sp[c * 1024 + k] * wv;
  }
#pragma unroll
  for (int c = 0; c < 5; ++c) red[(wave * 5 + c) * 64 + lane] = acc[c];
  __syncthreads();
  for (int t2 = tid; t2 < 320; t2 += 256) {
    int c = t2 >> 6, ln = t2 & 63;
    float v = red[(0 * 5 + c) * 64 + ln] + red[(1 * 5 + c) * 64 + ln] + red[(2 * 5 + c) * 64 + ln] + red[(3 * 5 + c) * 64 + ln];
    v += p.b_ada[l * 6144 + jg * 64 + ln];
    ((float*)(p.ws + W_MOD))[(size_t)(l * 5 + c) * 6144 + jg * 64 + ln] = v;
  }
  __syncthreads();
}

DI void misc_job(const Params& p_in, int j) {
  Params p = p_in; launder_params(p);
  const int tid = tidx();
  if (j < 16) {
    float2* rb = (float2*)(p.ws + W_ROPEB);
    float2* rd = (float2*)(p.ws + W_ROPED);
    for (int idx = tid; idx < 64 * 32; idx += 256) {
      int t = j * 64 + (idx >> 5), pp = idx & 31;
      int fi = pp & 15;
      float inv = exp2f(-(float)fi * (13.287712379549449f / 16.f));
      float pos = (pp < 16) ? (float)(t >> 6) : (float)(t & 63);
      float a = pos * inv;
      rb[t * 32 + pp] = make_float2(cosf(a), sinf(a));
    }
    for (int idx = tid; idx < 64 * 16; idx += 256) {
      int t = j * 64 + (idx >> 4), pp = idx & 15;
      int fi = pp & 7;
      float inv = exp2f(-(float)fi * (13.287712379549449f / 8.f));
      float pos = (pp < 8) ? (float)(t >> 6) : (float)(t & 63);
      float a = pos * inv;
      rd[t * 16 + pp] = make_float2(cosf(a), sinf(a));
    }
  } else if (j == 16) {
    float* lbv = (float*)(p.ws + W_LBV);
    for (int idx = tid; idx < 1024; idx += 256) {
      float a0 = p.lb_logits[idx], a1 = p.lb_logits[1024 + idx];
      lbv[idx] = 0.f;
      lbv[1024 + idx] = sigmoidf_(a1 - a0);
    }
  }
}

DI void cache_job(const Params& p_in, int l, int j, char* smem) {
  Params p = p_in; launder_params(p);
  const int b = j >> 4, p0 = (j & 15) * 32;
  const int tid = tidx();
  const size_t cb = (size_t)(b * 2 + l) * 512 + p0;
  {
    const float* src = p.cgk + cb * 128;
    u16* dst = (u16*)(p.ws + W_KBL) + ((size_t)b * 1536 + p0) * 128;
    for (int idx = tid; idx < 32 * 32; idx += 256) {
      float4 v = ldnt4(src + idx * 4);
      *(uint2*)(dst + idx * 4) = pk4(v.x, v.y, v.z, v.w);
    }
  }
  tr32x128<true>(p.cgv + cb * 128, 128, (u16*)(p.ws + W_VBTL) + (size_t)b * 128 * 1536 + p0, 1536, smem);
  {
    const float* src = p.cnk + cb * 512;
    u16* dst = (u16*)(p.ws + W_NKC) + ((size_t)b * 512 + p0) * 512;
    for (int idx = tid; idx < 32 * 128; idx += 256) {
      float4 v = ldnt4(src + idx * 4);
      *(uint2*)(dst + idx * 4) = pk4(v.x, v.y, v.z, v.w);
    }
  }
  for (int cc = 0; cc < 4; ++cc)
    tr32x128<true>(p.cnv + cb * 512 + cc * 128, 512, (u16*)(p.ws + W_NVTL) + ((size_t)b * 512 + cc * 128) * 1536 + p0, 1536, smem);
  {
    const float* src = p.cckv + cb * 128;
    u16* dst = (u16*)(p.ws + W_ACKV) + ((size_t)8192 + b * 512 + p0) * 128;
    for (int idx = tid; idx < 32 * 32; idx += 256) {
      float4 v = ldnt4(src + idx * 4);
      *(uint2*)(dst + idx * 4) = pk4(v.x, v.y, v.z, v.w);
    }
  }
  {
    const int r = tid >> 3, li = tid & 7;
    float4 v = ldnt4(p.ckr + (cb + r) * 32 + li * 4);
    uint2 o = pk4(v.x, v.y, v.z, v.w);
    u16* dst = (u16*)(p.ws + W_KDL) + ((size_t)b * 1536 + p0 + r) * 768 + 64 + li * 4;
#pragma unroll
    for (int h = 0; h < 8; ++h) *(uint2*)(dst + h * 96) = o;
  }
}

DI void norm_job(const Params& p_in, int l, int which, int job, bool from_input) {
  Params p = p_in; launder_params(p);
  const int tid = tidx(), lane = tid & 63, wave = tid >> 6;
  const int row = job * 4 + wave;
  const float* xs;
  if (from_input) xs = row < NCTX ? p.x_prompt + (size_t)row * D : p.x_sample + (size_t)(row - NCTX) * D;
  else xs = p.out + (size_t)row * D;
  float4 v[4];
  float ss = 0.f;
#pragma unroll
  for (int i = 0; i < 4; ++i) {
    v[i] = from_input ? ldnt4(xs + (i * 64 + lane) * 4) : *(const float4*)(xs + (i * 64 + lane) * 4);
    ss += v[i].x * v[i].x + v[i].y * v[i].y + v[i].z * v[i].z + v[i].w * v[i].w;
  }
#pragma unroll
  for (int o = 32; o >= 1; o >>= 1) ss += shx(ss, o);
  const float rstd = rsqrtf(ss * (1.f / 1024.f) + EPS);
  const int cond = cond_of_row(row);
  const float* mod = (const float*)(p.ws + W_MOD) + (size_t)(l * 5 + cond) * 6144;
  const float* sh = mod + (which ? 3 : 0) * 1024;
  const float* sc = mod + (which ? 4 : 1) * 1024;
  u16* hb = (u16*)(p.ws + W_H) + (size_t)row * D;
#pragma unroll
  for (int i = 0; i < 4; ++i) {
    int c = (i * 64 + lane) * 4;
    float4 a = *(const float4*)(sc + c), s = *(const float4*)(sh + c);
    *(uint2*)(hb + c) = pk4(v[i].x * rstd * (1.f + a.x) + s.x, v[i].y * rstd * (1.f + a.y) + s.y,
                            v[i].z * rstd * (1.f + a.z) + s.z, v[i].w * rstd * (1.f + a.w) + s.w);
    if (from_input) *(float4*)(p.out + (size_t)row * D + c) = v[i];
  }
}

DI void final_norm_job(const Params& p_in, int job) {
  Params p = p_in; launder_params(p);
  const int tid = tidx(), lane = tid & 63, wave = tid >> 6;
  const int row = job * 4 + wave;
  float* xs = p.out + (size_t)row * D;
  float4 v[4];
  float ss = 0.f;
#pragma unroll
  for (int i = 0; i < 4; ++i) {
    v[i] = *(const float4*)(xs + (i * 64 + lane) * 4);
    ss += v[i].x * v[i].x + v[i].y * v[i].y + v[i].z * v[i].z + v[i].w * v[i].w;
  }
#pragma unroll
  for (int o = 32; o >= 1; o >>= 1) ss += shx(ss, o);
  const float rstd = rsqrtf(ss * (1.f / 1024.f) + EPS);
#pragma unroll
  for (int i = 0; i < 4; ++i) {
    int c = (i * 64 + lane) * 4;
    float4 g = *(const float4*)(p.final_gain + c);
    stnt4(xs + c, make_float4(v[i].x * rstd * g.x, v[i].y * rstd * g.y, v[i].z * rstd * g.z, v[i].w * rstd * g.w));
  }
}

DI void prep_job(const Params& p_in, int l, int tile, int part, char* smem) {
  Params p = p_in; launder_params(p);
  const int row0 = tile * 32;
  const bool ctx = row0 < NCTX;
  int b, t0;
  if (ctx) { b = row0 >> 8; t0 = row0 & 255; } else { int rr = row0 - NCTX; b = rr >> 10; t0 = rr & 1023; }
  const u16* pr = (const u16*)(p.ws + W_PROJ) + (size_t)row0 * PW;
  const int tid = tidx(), lane = tid & 63, wave = tid >> 6;
  const float2* ropeB = (const float2*)(p.ws + W_ROPEB);
  const float2* ropeD = (const float2*)(p.ws + W_ROPED);
  const size_t cbase = (size_t)(b * 2 + l) * 256 + t0;

  if (part == 0) {
    const int li = tid & 15;
    const float4 gn = *(const float4*)(p.gq_q_gain + l * 64 + li * 4);
#pragma unroll 8
    for (int pass = 0; pass < 16; ++pass) {
      int vec = pass * 16 + (tid >> 4);
      int r = vec >> 3, h = vec & 7;
      float x[4];
      unpack4(*(const uint2*)(pr + (size_t)r * PW + C_GQ + h * 64 + li * 4), x);
      float ss = x[0] * x[0] + x[1] * x[1] + x[2] * x[2] + x[3] * x[3];
      ss += shx(ss, 1); ss += shx(ss, 2); ss += shx(ss, 4); ss += shx(ss, 8);
      float rstd = rsqrtf(ss * (1.f / 64.f) + EPS);
      float y0 = x[0] * rstd * gn.x, y1 = x[1] * rstd * gn.y, y2 = x[2] * rstd * gn.z, y3 = x[3] * rstd * gn.w;
      if (!ctx) {
        float2 c0 = ropeB[(t0 + r) * 32 + 2 * li], c1 = ropeB[(t0 + r) * 32 + 2 * li + 1];
        float a0 = y0 * c0.x - y1 * c0.y, a1 = y0 * c0.y + y1 * c0.x;
        float a2 = y2 * c1.x - y3 * c1.y, a3 = y2 * c1.y + y3 * c1.x;
        y0 = a0; y1 = a1; y2 = a2; y3 = a3;
      }
      *(uint2*)((u16*)(p.ws + W_QBF) + (size_t)(row0 + r) * 512 + h * 64 + li * 4) = pk4(y0, y1, y2, y3);
    }
  }
  if (part == 0) {
    const int li = tid & 15;
    const float4 gn = *(const float4*)(p.gq_k_gain + l * 64 + li * 4);
#pragma unroll
    for (int pass = 0; pass < 4; ++pass) {
      int vec = pass * 16 + (tid >> 4);
      int r = vec >> 1, kvh = vec & 1;
      float x[4];
      unpack4(*(const uint2*)(pr + (size_t)r * PW + C_GK + kvh * 64 + li * 4), x);
      float ss = x[0] * x[0] + x[1] * x[1] + x[2] * x[2] + x[3] * x[3];
      ss += shx(ss, 1); ss += shx(ss, 2); ss += shx(ss, 4); ss += shx(ss, 8);
      float rstd = rsqrtf(ss * (1.f / 64.f) + EPS);
      float y0 = x[0] * rstd * gn.x, y1 = x[1] * rstd * gn.y, y2 = x[2] * rstd * gn.z, y3 = x[3] * rstd * gn.w;
      if (ctx) {
        stnt4(p.out + O_GQK + (cbase + r) * 128 + kvh * 64 + li * 4, make_float4(y0, y1, y2, y3));
        *(uint2*)((u16*)(p.ws + W_KBC) + (size_t)(row0 + r) * 128 + kvh * 64 + li * 4) = pk4(y0, y1, y2, y3);
      } else {
        float2 c0 = ropeB[(t0 + r) * 32 + 2 * li], c1 = ropeB[(t0 + r) * 32 + 2 * li + 1];
        float a0 = y0 * c0.x - y1 * c0.y, a1 = y0 * c0.y + y1 * c0.x;
        float a2 = y2 * c1.x - y3 * c1.y, a3 = y2 * c1.y + y3 * c1.x;
        *(uint2*)((u16*)(p.ws + W_KBL) + ((size_t)b * 1536 + 512 + t0 + r) * 128 + kvh * 64 + li * 4) = pk4(a0, a1, a2, a3);
      }
    }
  }
  if (part == 1) {
  if (ctx) {
    for (int idx = tid; idx < 32 * 32; idx += 256) {
      int r = idx >> 5, c4 = (idx & 31) * 4;
      float x[4];
      unpack4(*(const uint2*)(pr + (size_t)r * PW + C_GV + c4), x);
      stnt4(p.out + O_GQV + (cbase + r) * 128 + c4, make_float4(x[0], x[1], x[2], x[3]));
    }
    tr32x128<false>(pr + C_GV, PW, (u16*)(p.ws + W_VBTC) + (size_t)b * 128 * 256 + t0, 256, smem);
  } else {
    tr32x128<false>(pr + C_GV, PW, (u16*)(p.ws + W_VBTL) + (size_t)b * 128 * 1536 + 512 + t0, 1536, smem);
  }
  if (ctx) {
    for (int idx = tid; idx < 32 * 128; idx += 256) {
      int r = idx >> 7, c4 = (idx & 127) * 4;
      float x[4];
      unpack4(*(const uint2*)(pr + (size_t)r * PW + C_NK + c4), x);
      stnt4(p.out + O_NAK + (cbase + r) * 512 + c4, make_float4(x[0], x[1], x[2], x[3]));
      unpack4(*(const uint2*)(pr + (size_t)r * PW + C_NV + c4), x);
      stnt4(p.out + O_NAV + (cbase + r) * 512 + c4, make_float4(x[0], x[1], x[2], x[3]));
    }
    for (int cc = 0; cc < 4; ++cc)
      tr32x128<false>(pr + C_NV + cc * 128, PW, (u16*)(p.ws + W_NVTC) + ((size_t)b * 512 + cc * 128) * 256 + t0, 256, smem);
  } else {
    for (int cc = 0; cc < 4; ++cc)
      tr32x128<false>(pr + C_NV + cc * 128, PW, (u16*)(p.ws + W_NVTL) + ((size_t)b * 512 + cc * 128) * 1536 + 512 + t0, 1536, smem);
  }
  }
  if (part == 0) {
    const float4 gn = *(const float4*)(p.ml_q_a_gain + l * 256 + lane * 4);
#pragma unroll
    for (int pass = 0; pass < 8; ++pass) {
      int r = pass * 4 + wave;
      float x[4];
      unpack4(*(const uint2*)(pr + (size_t)r * PW + C_MQA + lane * 4), x);
      float ss = x[0] * x[0] + x[1] * x[1] + x[2] * x[2] + x[3] * x[3];
#pragma unroll
      for (int o = 32; o >= 1; o >>= 1) ss += shx(ss, o);
      float rstd = rsqrtf(ss * (1.f / 256.f) + EPS);
      *(uint2*)((u16*)(p.ws + W_AQ) + (size_t)(row0 + r) * 256 + lane * 4) =
          pk4(x[0] * rstd * gn.x, x[1] * rstd * gn.y, x[2] * rstd * gn.z, x[3] * rstd * gn.w);
    }
  }
  if (part == 0) {
    const int li = tid & 31;
    const float4 gn = *(const float4*)(p.ml_kv_a_gain + l * 128 + li * 4);
#pragma unroll
    for (int pass = 0; pass < 4; ++pass) {
      int r = pass * 8 + (tid >> 5);
      float x[4];
      unpack4(*(const uint2*)(pr + (size_t)r * PW + C_MKVA + li * 4), x);
      float ss = x[0] * x[0] + x[1] * x[1] + x[2] * x[2] + x[3] * x[3];
#pragma unroll
      for (int o = 16; o >= 1; o >>= 1) ss += shx(ss, o);
      float rstd = rsqrtf(ss * (1.f / 128.f) + EPS);
      float y0 = x[0] * rstd * gn.x, y1 = x[1] * rstd * gn.y, y2 = x[2] * rstd * gn.z, y3 = x[3] * rstd * gn.w;
      *(uint2*)((u16*)(p.ws + W_ACKV) + (size_t)(row0 + r) * 128 + li * 4) = pk4(y0, y1, y2, y3);
      if (ctx) stnt4(p.out + O_CKV + (cbase + r) * 128 + li * 4, make_float4(y0, y1, y2, y3));
    }
  }
  if (part == 0) {
    const int r = tid >> 3, li = tid & 7;
    float x[4];
    unpack4(*(const uint2*)(pr + (size_t)r * PW + C_MKR + li * 4), x);
    if (ctx) {
      stnt4(p.out + O_KR + (cbase + r) * 32 + li * 4, make_float4(x[0], x[1], x[2], x[3]));
      uint2 o = pk4(x[0], x[1], x[2], x[3]);
      u16* dst = (u16*)(p.ws + W_KDC) + (size_t)(row0 + r) * 768 + 64 + li * 4;
#pragma unroll
      for (int h = 0; h < 8; ++h) *(uint2*)(dst + h * 96) = o;
    } else {
      float2 c0 = ropeD[(t0 + r) * 16 + 2 * li], c1 = ropeD[(t0 + r) * 16 + 2 * li + 1];
      float a0 = x[0] * c0.x - x[1] * c0.y, a1 = x[0] * c0.y + x[1] * c0.x;
      float a2 = x[2] * c1.x - x[3] * c1.y, a3 = x[2] * c1.y + x[3] * c1.x;
      uint2 o = pk4(a0, a1, a2, a3);
      u16* dst = (u16*)(p.ws + W_KDL) + ((size_t)b * 1536 + 512 + t0 + r) * 768 + 64 + li * 4;
#pragma unroll
      for (int h = 0; h < 8; ++h) *(uint2*)(dst + h * 96) = o;
    }
  }
}

struct AttnP {
  const u16* q; size_t qs;
  const u16* k; size_t ks;
  const u16* vt; size_t vs;
  int ntiles;
  float sscale;
  u16* o; size_t os;
  const float2* rope; int tq;
  const u16* k2; size_t ks2;
  int grow, c0;
  int krlo;
  const float* rpbs;
};

template <int DK, int MODE>
DI void attn_block(const AttnP& a, char* smem) {
  constexpr int NS = DK / 16;
  constexpr int KROW = DK * 2 + 16;
  constexpr int VROW = 144;
  constexpr int KCH = DK / 8;
  constexpr int KPT = KCH * 64 / 256;
  char* Ks = smem;
  char* Vs = smem + 2 * 64 * KROW;
  const int tid = tidx(), lane = tid & 63, r = lane & 31, g = lane >> 5;
  bf16x8 qf[NS];
#pragma unroll
  for (int s = 0; s < NS; ++s) qf[s] = *(const bf16x8*)(a.q + (size_t)r * a.qs + 16 * s + 8 * g);
  if (MODE == 1) {
#pragma unroll
    for (int s = 4; s < 6; ++s) {
      uint4 u = __builtin_bit_cast(uint4, qf[s]);
      float x[8];
      unpack8(u, x);
      const float2* rp = a.rope + (size_t)(a.tq + r) * 16 + (s - 4) * 8 + 4 * g;
      float y[8];
#pragma unroll
      for (int pp = 0; pp < 4; ++pp) {
        float2 cs = rp[pp];
        y[2 * pp] = x[2 * pp] * cs.x - x[2 * pp + 1] * cs.y;
        y[2 * pp + 1] = x[2 * pp] * cs.y + x[2 * pp + 1] * cs.x;
      }
      uint4 o;
      o.x = pk2(y[0], y[1]); o.y = pk2(y[2], y[3]); o.z = pk2(y[4], y[5]); o.w = pk2(y[6], y[7]);
      qf[s] = __builtin_bit_cast(bf16x8, o);
    }
  }
  f32x16 oacc[2];
#pragma unroll
  for (int i = 0; i < 16; ++i) { oacc[0][i] = 0.f; oacc[1][i] = 0.f; }
  float m = -1e30f, lsum = 0.f;
  int kr0 = 0, qc = 0, cs0 = 0;
  if (MODE == 2) {
    kr0 = a.grow - 4; kr0 = kr0 < 0 ? 0 : (kr0 > 8 ? 8 : kr0);
    qc = a.c0 + r;
    cs0 = qc - 8; cs0 = cs0 < 0 ? 0 : (cs0 > 48 ? 48 : cs0);
  }
  u32x4 rk[KPT], rv[2];
  int krow_i[KPT], kkc[KPT];
#pragma unroll
  for (int i = 0; i < KPT; ++i) { int c = tid + 256 * i; krow_i[i] = c / KCH; kkc[i] = c % KCH; }
  const int vrow_i = tid >> 3, vkc = tid & 7;
#define ATT_GLOAD(KT)                                                                                   \
  {                                                                                                     \
    const u16* kb_;                                                                                     \
    size_t kst_;                                                                                        \
    int vkey_;                                                                                          \
    if (MODE == 2 && (KT) >= 8) {                                                                       \
      int tok_ = (a.krlo + (KT) - 8) * 64;                                                              \
      kb_ = a.k2 + (size_t)tok_ * a.ks2; kst_ = a.ks2; vkey_ = 512 + tok_;                              \
    } else {                                                                                            \
      kb_ = a.k + (size_t)((KT) * 64) * a.ks; kst_ = a.ks; vkey_ = (KT) * 64;                           \
    }                                                                                                   \
    _Pragma("unroll") for (int i = 0; i < KPT; ++i)                                                     \
      rk[i] = *(const u32x4*)(kb_ + (size_t)krow_i[i] * kst_ + kkc[i] * 8);                             \
    rv[0] = *(const u32x4*)(a.vt + (size_t)vrow_i * a.vs + vkey_ + vkc * 8);                            \
    rv[1] = *(const u32x4*)(a.vt + (size_t)(vrow_i + 32) * a.vs + vkey_ + vkc * 8);                     \
  }
#define ATT_SSTORE(BUF)                                                                                 \
  {                                                                                                     \
    _Pragma("unroll") for (int i = 0; i < KPT; ++i)                                                     \
      *(u32x4*)(Ks + ((BUF) * 64 + krow_i[i]) * KROW + kkc[i] * 16) = rk[i];                            \
    *(u32x4*)(Vs + ((BUF) * 64 + vrow_i) * VROW + vkc * 16) = rv[0];                                    \
    *(u32x4*)(Vs + ((BUF) * 64 + vrow_i + 32) * VROW + vkc * 16) = rv[1];                               \
  }
  ATT_GLOAD(0)
  ATT_SSTORE(0)
  __syncthreads();
  for (int kt = 0; kt < a.ntiles; ++kt) {
    const int buf = kt & 1;
    const int ktn = (kt + 1 < a.ntiles) ? kt + 1 : kt;
    ATT_GLOAD(ktn)
    __builtin_amdgcn_sched_barrier(0);
    float sv[2][16];
#pragma unroll
    for (int u = 0; u < 2; ++u) {
      f32x16 sacc;
#pragma unroll
      for (int i = 0; i < 16; ++i) sacc[i] = 0.f;
      const char* kp = Ks + (buf * 64 + u * 32 + r) * KROW + g * 16;
#pragma unroll
      for (int s = 0; s < NS; ++s) sacc = MFMA32(*(const bf16x8*)(kp + s * 32), qf[s], sacc);
#pragma unroll
      for (int i = 0; i < 16; ++i) sv[u][i] = sacc[i];
    }
    float mn;
    if (MODE == 2 && kt >= 8) {
      const int krow_ = a.krlo + kt - 8;
      const bool rowok = (krow_ >= kr0) && (krow_ < kr0 + 8);
      int dr = krow_ - a.grow + 7;
      dr = dr < 0 ? 0 : (dr > 14 ? 14 : dr);
#pragma unroll
      for (int u = 0; u < 2; ++u)
#pragma unroll
        for (int i = 0; i < 16; ++i) {
          int kc = u * 32 + crow(i, g);
          bool ok = rowok && (kc >= cs0) && (kc < cs0 + 16);
          int dc = kc - qc + 15; dc = dc < 0 ? 0 : (dc > 30 ? 30 : dc);
          sv[u][i] = ok ? fmaf(sv[u][i], a.sscale, a.rpbs[dr * 31 + dc]) : -INFINITY;
        }
      float mx = sv[0][0];
#pragma unroll
      for (int u = 0; u < 2; ++u)
#pragma unroll
        for (int i = 0; i < 16; ++i) mx = fmaxf(mx, sv[u][i]);
      mx = fmaxf(mx, shx(mx, 32));
      mn = fmaxf(m, mx);
#pragma unroll
      for (int u = 0; u < 2; ++u)
#pragma unroll
        for (int i = 0; i < 16; ++i) sv[u][i] = __builtin_amdgcn_exp2f(sv[u][i] - mn);
    } else {
      float mx = sv[0][0];
#pragma unroll
      for (int u = 0; u < 2; ++u)
#pragma unroll
        for (int i = 0; i < 16; ++i) mx = fmaxf(mx, sv[u][i]);
      mx = fmaxf(mx, shx(mx, 32)) * a.sscale;
      mn = fmaxf(m, mx);
#pragma unroll
      for (int u = 0; u < 2; ++u)
#pragma unroll
        for (int i = 0; i < 16; ++i) sv[u][i] = __builtin_amdgcn_exp2f(fmaf(sv[u][i], a.sscale, -mn));
    }
    float ps = 0.f;
#pragma unroll
    for (int u = 0; u < 2; ++u)
#pragma unroll
      for (int i = 0; i < 16; ++i) ps += sv[u][i];
    if (__any(mn > m)) {
      const float alpha = __builtin_amdgcn_exp2f(m - mn);
      lsum *= alpha;
#pragma unroll
      for (int i = 0; i < 16; ++i) { oacc[0][i] *= alpha; oacc[1][i] *= alpha; }
      m = mn;
    }
    lsum += ps;
    ATT_SSTORE(buf ^ 1)
#pragma unroll
    for (int u = 0; u < 2; ++u)
#pragma unroll
      for (int s2 = 0; s2 < 2; ++s2) {
        uint4 pu;
        pu.x = pk2(sv[u][8 * s2 + 0], sv[u][8 * s2 + 1]); pu.y = pk2(sv[u][8 * s2 + 2], sv[u][8 * s2 + 3]);
        pu.z = pk2(sv[u][8 * s2 + 4], sv[u][8 * s2 + 5]); pu.w = pk2(sv[u][8 * s2 + 6], sv[u][8 * s2 + 7]);
        const bf16x8 pf = __builtin_bit_cast(bf16x8, pu);
#pragma unroll
        for (int mb = 0; mb < 2; ++mb) {
          const char* vp = Vs + (buf * 64 + mb * 32 + r) * VROW + (u * 32 + 16 * s2 + 4 * g) * 2;
          bf16x4 lo = *(const bf16x4*)(vp);
          bf16x4 hi = *(const bf16x4*)(vp + 16);
          oacc[mb] = MFMA32(__builtin_shufflevector(lo, hi, 0, 1, 2, 3, 4, 5, 6, 7), pf, oacc[mb]);
        }
      }
    __syncthreads();
  }
#undef ATT_GLOAD
#undef ATT_SSTORE
  lsum += shx(lsum, 32);
  const float inv = frcp(lsum);
#pragma unroll
  for (int mb = 0; mb < 2; ++mb)
#pragma unroll
    for (int q4 = 0; q4 < 4; ++q4) {
      int dv = mb * 32 + 8 * q4 + 4 * g;
      *(uint2*)(a.o + (size_t)r * a.os + dv) = pk4(oacc[mb][4 * q4 + 0] * inv, oacc[mb][4 * q4 + 1] * inv,
                                                    oacc[mb][4 * q4 + 2] * inv, oacc[mb][4 * q4 + 3] * inv);
    }
}

DI void gqa_item(const Params& p_in, int lat, int item, char* smem) {
  Params p = p_in; launder_params(p);
  const int wave = tidx() >> 6;
  AttnP a;
  a.sscale = 0.125f * LOG2E;
  a.rope = nullptr; a.tq = 0; a.k2 = nullptr; a.ks2 = 0; a.grow = 0; a.c0 = 0; a.rpbs = nullptr; a.krlo = 0;
  if (lat) {
    int b = item >> 6, h = (item >> 3) & 7, qt = item & 7;
    int row = NCTX + b * 1024 + qt * 128 + wave * 32;
    a.q = (const u16*)(p.ws + W_QBF) + (size_t)row * 512 + h * 64; a.qs = 512;
    a.k = (const u16*)(p.ws + W_KBL) + (size_t)b * 1536 * 128 + (h >> 2) * 64; a.ks = 128;
    a.vt = (const u16*)(p.ws + W_VBTL) + ((size_t)b * 128 + (h >> 2) * 64) * 1536; a.vs = 1536;
    a.ntiles = 24;
    a.o = (u16*)(p.ws + W_BRANCH) + (size_t)row * 2048 + 512 + h * 64; a.os = 2048;
  } else {
    int b = item >> 4, h = (item >> 1) & 7, qt = item & 1;
    int row = b * 256 + qt * 128 + wave * 32;
    a.q = (const u16*)(p.ws + W_QBF) + (size_t)row * 512 + h * 64; a.qs = 512;
    a.k = (const u16*)(p.ws + W_KBC) + (size_t)b * 256 * 128 + (h >> 2) * 64; a.ks = 128;
    a.vt = (const u16*)(p.ws + W_VBTC) + ((size_t)b * 128 + (h >> 2) * 64) * 256; a.vs = 256;
    a.ntiles = 4;
    a.o = (u16*)(p.ws + W_BRANCH) + (size_t)row * 2048 + 512 + h * 64; a.os = 2048;
  }
  attn_block<64, 0>(a, smem);
}

DI void na_ctx_item(const Params& p_in, int item, char* smem) {
  Params p = p_in; launder_params(p);
  const int wave = tidx() >> 6;
  AttnP a;
  a.sscale = 0.125f * LOG2E;
  a.rope = nullptr; a.tq = 0; a.k2 = nullptr; a.ks2 = 0; a.grow = 0; a.c0 = 0; a.rpbs = nullptr; a.krlo = 0;
  int b = item >> 4, h = (item >> 1) & 7, qt = item & 1;
  int row = b * 256 + qt * 128 + wave * 32;
  const u16* pr = (const u16*)(p.ws + W_PROJ);
  a.q = pr + (size_t)row * PW + C_NQ + h * 64; a.qs = PW;
  a.k = pr + (size_t)(b * 256) * PW + C_NK + h * 64; a.ks = PW;
  a.vt = (const u16*)(p.ws + W_NVTC) + ((size_t)b * 512 + h * 64) * 256; a.vs = 256;
  a.ntiles = 4;
  a.o = (u16*)(p.ws + W_BRANCH) + (size_t)row * 2048 + 1024 + h * 64; a.os = 2048;
  attn_block<64, 0>(a, smem);
}

DI void na_lat_item(const Params& p_in, int l, int item, char* smem) {
  Params p = p_in; launder_params(p);
  const int tid = tidx(), wave = tid >> 6;
  int b = item >> 6, h = (item >> 3) & 7, rp = item & 7;
  float* rpbs = (float*)(smem + 65536);
  for (int idx = tid; idx < 15 * 31; idx += 256) rpbs[idx] = p.na_rpb[(size_t)(l * 8 + h) * 465 + idx] * LOG2E;
  __syncthreads();
  AttnP a;
  a.sscale = 0.125f * LOG2E;
  a.rope = nullptr; a.tq = 0;
  const int grow = rp * 2 + (wave >> 1), c0 = (wave & 1) * 32;
  int row = NCTX + b * 1024 + grow * 64 + c0;
  const u16* pr = (const u16*)(p.ws + W_PROJ);
  a.q = pr + (size_t)row * PW + C_NQ + h * 64; a.qs = PW;
  a.k = (const u16*)(p.ws + W_NKC) + (size_t)b * 512 * 512 + h * 64; a.ks = 512;
  a.vt = (const u16*)(p.ws + W_NVTL) + ((size_t)b * 512 + h * 64) * 1536; a.vs = 1536;
  a.k2 = pr + (size_t)(NCTX + b * 1024) * PW + C_NK + h * 64; a.ks2 = PW;
  a.grow = grow; a.c0 = c0; a.rpbs = rpbs;
  int lo = rp * 2 - 4; lo = lo < 0 ? 0 : (lo > 8 ? 8 : lo);
  int hi = rp * 2 + 1 - 4; hi = hi < 0 ? 0 : (hi > 8 ? 8 : hi);
  a.krlo = lo;
  a.ntiles = 8 + (hi + 8 - lo);
  a.o = (u16*)(p.ws + W_BRANCH) + (size_t)row * 2048 + 1024 + h * 64; a.os = 2048;
  attn_block<64, 2>(a, smem);
}

DI void mla_item(const Params& p_in, int lat, int item, char* smem) {
  Params p = p_in; launder_params(p);
  const int wave = tidx() >> 6;
  AttnP a;
  a.sscale = 0.10206207261596577f * LOG2E;
  a.rope = (const float2*)(p.ws + W_ROPED); a.tq = 0; a.k2 = nullptr; a.ks2 = 0; a.grow = 0; a.c0 = 0; a.rpbs = nullptr; a.krlo = 0;
  if (lat) {
    int b = item >> 6, h = (item >> 3) & 7, qt = item & 7;
    int t = qt * 128 + wave * 32;
    int row = NCTX + b * 1024 + t;
    a.tq = t;
    a.q = (const u16*)(p.ws + W_QD) + (size_t)row * 768 + h * 96; a.qs = 768;
    a.k = (const u16*)(p.ws + W_KDL) + (size_t)b * 1536 * 768 + h * 96; a.ks = 768;
    a.vt = (const u16*)(p.ws + W_VDTL) + ((size_t)b * 512 + h * 64) * 1536; a.vs = 1536;
    a.ntiles = 24;
    a.o = (u16*)(p.ws + W_BRANCH) + (size_t)row * 2048 + 1536 + h * 64; a.os = 2048;
    attn_block<96, 1>(a, smem);
  } else {
    int b = item >> 4, h = (item >> 1) & 7, qt = item & 1;
    int row = b * 256 + qt * 128 + wave * 32;
    a.q = (const u16*)(p.ws + W_QD) + (size_t)row * 768 + h * 96; a.qs = 768;
    a.k = (const u16*)(p.ws + W_KDC) + (size_t)(b * 256) * 768 + h * 96; a.ks = 768;
    a.vt = (const u16*)(p.ws + W_VDTC) + ((size_t)b * 512 + h * 64) * 256; a.vs = 256;
    a.ntiles = 4;
    a.o = (u16*)(p.ws + W_BRANCH) + (size_t)row * 2048 + 1536 + h * 64; a.os = 2048;
    attn_block<96, 0>(a, smem);
  }
}

DI void hgrn_item(const Params& p_in, int l, int lat, int item, char* smem) {
  Params p = p_in; launder_params(p);
  const int tid = tidx();
  const int seq = item >> 3, vsl = item & 7;
  const int dir = seq & 1, h = (seq >> 1) & 3, b = seq >> 3;
  const int T = lat ? 1024 : 256;
  const int rowbase = lat ? NCTX + b * 1024 : b * 256;
  const int vi = tid & 15, kg = tid >> 4;
  float* qs = (float*)smem;
  float* fs = qs + 2 * 16 * 128;
  float* vsm = fs + 2 * 16 * 128;
  float* red = vsm + 2 * 16 * 16;
  f32x2 S2[4];
  if (lat) {
    const float* sp = p.state_hgrn + ((((size_t)(b * 2 + l) * 2 + dir) * 4 + h) * 128 + kg * 8) * 128 + vsl * 16 + vi;
#pragma unroll
    for (int kk = 0; kk < 4; ++kk) { S2[kk][0] = sp[(2 * kk) * 128]; S2[kk][1] = sp[(2 * kk + 1) * 128]; }
  } else {
#pragma unroll
    for (int kk = 0; kk < 4; ++kk) { S2[kk][0] = 0.f; S2[kk][1] = 0.f; }
  }
  const u16* pr = (const u16*)(p.ws + W_PROJ);
  const int ltok = tid >> 4, lk8 = (tid & 15) * 8;
  float lb[8];
  {
    const float* lp = (const float*)(p.ws + W_LBV) + (l * 2 + dir) * 512 + h * 128 + lk8;
#pragma unroll
    for (int i = 0; i < 8; ++i) lb[i] = lp[i];
  }
  const int fcol = (dir ? C_HFB : C_HFF) + h * 128 + lk8;
  const int qcol = C_HQ + h * 128 + lk8;
  const int vcol = C_HI + h * 128 + vsl * 16 + vi;
  const int nchunk = T >> 4;
  uint4 rq, rf;
  u16 rv;
  auto tokidx = [&](int c, int j) { int s = c * 16 + j; return dir ? (T - 1 - s) : s; };
  auto gload = [&](int c) {
    size_t ro = (size_t)(rowbase + tokidx(c, ltok)) * PW;
    rq = *(const uint4*)(pr + ro + qcol);
    rf = *(const uint4*)(pr + ro + fcol);
    rv = pr[ro + vcol];
  };
  auto sstore = [&](int buf) {
    float q8[8], f8[8];
    unpack8(rq, q8);
    unpack8(rf, f8);
    float* qd = qs + (buf * 16 + ltok) * 128 + lk8;
    float* fd = fs + (buf * 16 + ltok) * 128 + lk8;
#pragma unroll
    for (int i = 0; i < 8; ++i) {
      qd[i] = q8[i] * 0.08838834764831845f;
      fd[i] = lb[i] + (1.f - lb[i]) * sigmoidf_(f8[i]);
    }
    vsm[(buf * 16 + ltok) * 16 + vi] = bf2f(rv);
  };
  gload(0);
  sstore(0);
  __syncthreads();
  u16* obase = dir ? (u16*)(p.ws + W_OB) : (u16*)(p.ws + W_BRANCH);
  const size_t ostride = dir ? 512 : 2048;
#define HG_LD(J, FA, FB, QA, QB, VV)                                    \
  {                                                                     \
    const float* fp_ = fs + (buf * 16 + (J)) * 128 + kg * 8;            \
    const float* qp_ = qs + (buf * 16 + (J)) * 128 + kg * 8;            \
    FA = *(const float4*)(fp_); FB = *(const float4*)(fp_ + 4);         \
    QA = *(const float4*)(qp_); QB = *(const float4*)(qp_ + 4);         \
    VV = vsm[(buf * 16 + (J)) * 16 + vi];                               \
  }
#define HG_STEP(J, FA, FB, QA, QB, VV)                                  \
  {                                                                     \
    const f32x2 v2 = {VV, VV};                                          \
    const f32x2 f0 = {FA.x, FA.y}, f1 = {FA.z, FA.w}, f2 = {FB.x, FB.y}, f3 = {FB.z, FB.w}; \
    const f32x2 q0 = {QA.x, QA.y}, q1 = {QA.z, QA.w}, q2 = {QB.x, QB.y}, q3 = {QB.z, QB.w}; \
    S2[0] = f0 * (S2[0] - v2) + v2;                                     \
    S2[1] = f1 * (S2[1] - v2) + v2;                                     \
    S2[2] = f2 * (S2[2] - v2) + v2;                                     \
    S2[3] = f3 * (S2[3] - v2) + v2;                                     \
    f32x2 op2 = S2[0] * q0;                                             \
    op2 = S2[1] * q1 + op2;                                             \
    op2 = S2[2] * q2 + op2;                                             \
    op2 = S2[3] * q3 + op2;                                             \
    red[((J) * 16 + kg) * 16 + vi] = op2[0] + op2[1];                   \
  }
  for (int c = 0; c < nchunk; ++c) {
    const int buf = c & 1;
    const int cn = (c + 1 < nchunk) ? c + 1 : c;
    gload(cn);
    __builtin_amdgcn_sched_barrier(0);
    float4 fa[2][4], fb[2][4], qa[2][4], qb[2][4];
    float vv[2][4];
#pragma unroll
    for (int t = 0; t < 4; ++t) HG_LD(t, fa[0][t], fb[0][t], qa[0][t], qb[0][t], vv[0][t])
#pragma unroll
    for (int jb = 0; jb < 4; ++jb) {
      if (jb < 3) {
#pragma unroll
        for (int t = 0; t < 4; ++t)
          HG_LD(jb * 4 + 4 + t, fa[(jb + 1) & 1][t], fb[(jb + 1) & 1][t], qa[(jb + 1) & 1][t], qb[(jb + 1) & 1][t], vv[(jb + 1) & 1][t])
      }
      __builtin_amdgcn_sched_barrier(0);
#pragma unroll
      for (int t = 0; t < 4; ++t) HG_STEP(jb * 4 + t, fa[jb & 1][t], fb[jb & 1][t], qa[jb & 1][t], qb[jb & 1][t], vv[jb & 1][t])
      __builtin_amdgcn_sched_barrier(0);
    }
    __syncthreads();
    {
      float o = 0.f;
#pragma unroll
      for (int k2 = 0; k2 < 16; ++k2) o += red[(ltok * 16 + k2) * 16 + vi];
      obase[(size_t)(rowbase + tokidx(c, ltok)) * ostride + h * 128 + vsl * 16 + vi] = f2bf(o);
    }
    sstore(buf ^ 1);
    __syncthreads();
  }
#undef HG_LD
#undef HG_STEP
  if (!lat) {
    float* sp = p.out + O_STATE + ((((size_t)(b * 2 + l) * 2 + dir) * 4 + h) * 128 + kg * 8) * 128 + vsl * 16 + vi;
#pragma unroll
    for (int kk = 0; kk < 4; ++kk) { sp[(2 * kk) * 128] = S2[kk][0]; sp[(2 * kk + 1) * 128] = S2[kk][1]; }
  }
}

DI void hgrn_mfma_item(const Params& p_in, int l, int lat, int seq, char* smem) {
  Params p = p_in; launder_params(p);
  const int tid = tidx(), lane = tid & 63, wave = tid >> 6, r = lane & 31, g = lane >> 5;
  const int dir = seq & 1, h = (seq >> 1) & 3, b = seq >> 3;
  const int T = lat ? 1024 : 256;
  const int rowbase = lat ? NCTX + b * 1024 : b * 256;
  constexpr int QROW = 272, EROW = 80;
  char* QT = smem;
  char* KT = QT + 32 * QROW;
  char* KE = KT + 32 * QROW;
  char* VT = KE + 128 * EROW;
  float* EMID = (float*)(VT + 128 * EROW);
  float* DEC = EMID + 128;
  float* TOT = DEC + 128;
  const int kk = tid & 127, hf = tid >> 7;
  f32x16 S[4];
  if (lat) {
    const float* sp = p.state_hgrn + (((size_t)(b * 2 + l) * 2 + dir) * 4 + h) * 16384 + wave * 32 + r;
#pragma unroll
    for (int kb = 0; kb < 4; ++kb)
#pragma unroll
      for (int i = 0; i < 16; ++i) S[kb][i] = sp[(size_t)(kb * 32 + crow(i, g)) * 128];
  } else {
#pragma unroll
    for (int kb = 0; kb < 4; ++kb)
#pragma unroll
      for (int i = 0; i < 16; ++i) S[kb][i] = 0.f;
  }
  const u16* pr = (const u16*)(p.ws + W_PROJ);
  const float lbk = ((const float*)(p.ws + W_LBV))[(l * 2 + dir) * 512 + h * 128 + kk];
  const int fcol = (dir ? C_HFB : C_HFF) + h * 128 + kk;
  const int qcol = C_HQ + h * 128 + kk;
  const int vcol = C_HI + h * 128 + kk;
  const int nchunk = T >> 5;
  u16 rf[16], rq[16], rv[16];
#define HG_GLOAD(C)                                                                  \
  {                                                                                  \
    _Pragma("unroll") for (int i = 0; i < 16; ++i) {                                 \
      int sp_ = (C) * 32 + hf * 16 + i;                                              \
      int tok_ = dir ? (T - 1 - sp_) : sp_;                                          \
      const u16* rp_ = pr + (size_t)(rowbase + tok_) * PW;                           \
      rf[i] = rp_[fcol]; rq[i] = rp_[qcol]; rv[i] = rp_[vcol];                       \
    }                                                                                \
  }
  u16* obase = dir ? (u16*)(p.ws + W_OB) : (u16*)(p.ws + W_BRANCH);
  const size_t ostride = dir ? 512 : 2048;
  HG_GLOAD(0)
  for (int c = 0; c < nchunk; ++c) {
    float kv[16], ef[16], qv[16];
    unsigned vp[8];
    float run = 1.f;
#pragma unroll
    for (int i = 0; i < 16; ++i) {
      qv[i] = bf2f(rq[i]) * 0.08838834764831845f;
      if (i & 1) vp[i >> 1] |= ((unsigned)rv[i]) << 16; else vp[i >> 1] = (unsigned)rv[i];
    }
    if (hf) {
#pragma unroll
      for (int i = 0; i < 16; ++i) {
        const float f = lbk + (1.f - lbk) * sigmoidf_(bf2f(rf[i]));
        kv[i] = 1.f - f;
        run *= f; ef[i] = run;
      }
    } else {
#pragma unroll
      for (int i = 15; i >= 0; --i) {
        const float f = lbk + (1.f - lbk) * sigmoidf_(bf2f(rf[i]));
        kv[i] = 1.f - f;
        ef[i] = run; run *= f;
      }
    }
    TOT[hf * 128 + kk] = run;
    {
      const int cn = (c + 1 < nchunk) ? c + 1 : c;
      HG_GLOAD(cn)
    }
    __builtin_amdgcn_sched_barrier(0);
    __syncthreads();
    {
      const float F0 = TOT[kk], F1 = TOT[128 + kk];
      unsigned ke[8];
#pragma unroll
      for (int i = 0; i < 16; ++i) {
        const int tl = hf * 16 + i;
        const float inv = frcp(ef[i]);
        const float eq = hf ? ef[i] : inv;
        const float ek = hf ? inv : ef[i];
        const float ee = ek * F1;
        *(u16*)(QT + tl * QROW + kk * 2) = f2bf(qv[i] * eq);
        *(u16*)(KT + tl * QROW + kk * 2) = f2bf(kv[i] * ek);
        const float ken = kv[i] * ee;
        if (i & 1) ke[i >> 1] = pk2(__uint_as_float(ke[i >> 1]), ken);
        else ke[i >> 1] = __float_as_uint(ken);
      }
      *(uint4*)(KE + kk * EROW + hf * 32) = make_uint4(ke[0], ke[1], ke[2], ke[3]);
      *(uint4*)(KE + kk * EROW + hf * 32 + 16) = make_uint4(ke[4], ke[5], ke[6], ke[7]);
      *(uint4*)(VT + kk * EROW + hf * 32) = make_uint4(vp[0], vp[1], vp[2], vp[3]);
      *(uint4*)(VT + kk * EROW + hf * 32 + 16) = make_uint4(vp[4], vp[5], vp[6], vp[7]);
      if (hf == 0) { EMID[kk] = F0; DEC[kk] = F0 * F1; }
    }
    __syncthreads();
    f32x16 oacc;
#pragma unroll
    for (int i = 0; i < 16; ++i) oacc[i] = 0.f;
#pragma unroll
    for (int kb = 0; kb < 4; ++kb) {
#pragma unroll
      for (int s = 0; s < 2; ++s) {
        const float4 e0 = *(const float4*)(EMID + kb * 32 + 16 * s + 4 * g);
        const float4 e1 = *(const float4*)(EMID + kb * 32 + 16 * s + 8 + 4 * g);
        uint4 au;
        au.x = pk2(S[kb][8 * s + 0] * e0.x, S[kb][8 * s + 1] * e0.y);
        au.y = pk2(S[kb][8 * s + 2] * e0.z, S[kb][8 * s + 3] * e0.w);
        au.z = pk2(S[kb][8 * s + 4] * e1.x, S[kb][8 * s + 5] * e1.y);
        au.w = pk2(S[kb][8 * s + 6] * e1.z, S[kb][8 * s + 7] * e1.w);
        const char* qp = QT + r * QROW + (kb * 32 + 16 * s + 4 * g) * 2;
        bf16x4 lo = *(const bf16x4*)(qp);
        bf16x4 hi = *(const bf16x4*)(qp + 16);
        oacc = MFMA32(__builtin_bit_cast(bf16x8, au), __builtin_shufflevector(lo, hi, 0, 1, 2, 3, 4, 5, 6, 7), oacc);
      }
    }
    f32x16 sacc;
#pragma unroll
    for (int i = 0; i < 16; ++i) sacc[i] = 0.f;
#pragma unroll
    for (int ks = 0; ks < 8; ++ks) {
      bf16x8 ka = *(const bf16x8*)(KT + r * QROW + (16 * ks + 8 * g) * 2);
      bf16x8 qb = *(const bf16x8*)(QT + r * QROW + (16 * ks + 8 * g) * 2);
      sacc = MFMA32(ka, qb, sacc);
    }
#pragma unroll
    for (int i = 0; i < 16; ++i) sacc[i] = (crow(i, g) <= r) ? sacc[i] : 0.f;
#pragma unroll
    for (int s2 = 0; s2 < 2; ++s2) {
      uint4 pu;
      pu.x = pk2(sacc[8 * s2 + 0], sacc[8 * s2 + 1]); pu.y = pk2(sacc[8 * s2 + 2], sacc[8 * s2 + 3]);
      pu.z = pk2(sacc[8 * s2 + 4], sacc[8 * s2 + 5]); pu.w = pk2(sacc[8 * s2 + 6], sacc[8 * s2 + 7]);
      const char* vq = VT + (wave * 32 + r) * EROW + (16 * s2 + 4 * g) * 2;
      bf16x4 lo = *(const bf16x4*)(vq);
      bf16x4 hi = *(const bf16x4*)(vq + 16);
      oacc = MFMA32(__builtin_shufflevector(lo, hi, 0, 1, 2, 3, 4, 5, 6, 7), __builtin_bit_cast(bf16x8, pu), oacc);
    }
    {
      int sp_ = c * 32 + r;
      int tok_ = dir ? (T - 1 - sp_) : sp_;
      u16* op = obase + (size_t)(rowbase + tok_) * ostride + h * 128 + wave * 32 + 4 * g;
#pragma unroll
      for (int q4 = 0; q4 < 4; ++q4)
        *(uint2*)(op + 8 * q4) = pk4(oacc[4 * q4 + 0], oacc[4 * q4 + 1], oacc[4 * q4 + 2], oacc[4 * q4 + 3]);
    }
#pragma unroll
    for (int kb = 0; kb < 4; ++kb) {
#pragma unroll
      for (int q4 = 0; q4 < 4; ++q4) {
        const float4 d4 = *(const float4*)(DEC + kb * 32 + 8 * q4 + 4 * g);
        S[kb][4 * q4 + 0] *= d4.x; S[kb][4 * q4 + 1] *= d4.y; S[kb][4 * q4 + 2] *= d4.z; S[kb][4 * q4 + 3] *= d4.w;
      }
#pragma unroll
      for (int s = 0; s < 2; ++s) {
        bf16x8 ka = *(const bf16x8*)(KE + (kb * 32 + r) * EROW + (16 * s + 8 * g) * 2);
        bf16x8 vb = *(const bf16x8*)(VT + (wave * 32 + r) * EROW + (16 * s + 8 * g) * 2);
        S[kb] = MFMA32(ka, vb, S[kb]);
      }
    }
    __syncthreads();
  }
#undef HG_GLOAD
  if (!lat) {
    float* sp = p.out + O_STATE + (((size_t)(b * 2 + l) * 2 + dir) * 4 + h) * 16384 + wave * 32 + r;
#pragma unroll
    for (int kb = 0; kb < 4; ++kb)
#pragma unroll
      for (int i = 0; i < 16; ++i) __builtin_nontemporal_store(S[kb][i], sp + (size_t)(kb * 32 + crow(i, g)) * 128);
  }
}

DI void hgrn_lat_pc(const Params& p_in, int l, int seq, int role, char* smem) {
  Params p = p_in; launder_params(p);
  const int tid = tidx(), lane = tid & 63, wave = tid >> 6, r = lane & 31, g = lane >> 5;
  const int dir = seq & 1, h = (seq >> 1) & 3, b = seq >> 3;
  const int T = 1024;
  const int rowbase = NCTX + b * 1024;
  constexpr int QROW = 272, EROW = 80;
  constexpr int BUFB = 2 * 32 * QROW + 2 * 128 * EROW + 1024;
  float* TOT = (float*)(smem + 2 * BUFB);
  const int kk = tid & 127, hf = tid >> 7;
  const int nchunk = T >> 5;
  const u16* pr = (const u16*)(p.ws + W_PROJ);
  if (role == 1) {
    const float lbk = ((const float*)(p.ws + W_LBV))[(l * 2 + dir) * 512 + h * 128 + kk];
    const int fcol = (dir ? C_HFB : C_HFF) + h * 128 + kk;
    const int qcol = C_HQ + h * 128 + kk;
    const int vcol = C_HI + h * 128 + kk;
    u16 rf[16], rq[16], rv[16];
#define HG_GLOAD(C)                                                                  \
  {                                                                                  \
    _Pragma("unroll") for (int i = 0; i < 16; ++i) {                                 \
      int sp_ = (C) * 32 + hf * 16 + i;                                              \
      int tok_ = dir ? (T - 1 - sp_) : sp_;                                          \
      const u16* rp_ = pr + (size_t)(rowbase + tok_) * PW;                           \
      rf[i] = rp_[fcol]; rq[i] = rp_[qcol]; rv[i] = rp_[vcol];                       \
    }                                                                                \
  }
    HG_GLOAD(0)
    for (int c = 0; c <= nchunk; ++c) {
      if (c < nchunk) {
        char* QT = smem + (c & 1) * BUFB;
        char* KT = QT + 32 * QROW;
        char* KE = KT + 32 * QROW;
        char* VT = KE + 128 * EROW;
        float* EMID = (float*)(VT + 128 * EROW);
        float* DEC = EMID + 128;
        float kv[16], ef[16], qv[16];
        unsigned vp[8];
        float run = 1.f;
#pragma unroll
        for (int i = 0; i < 16; ++i) {
          qv[i] = bf2f(rq[i]) * 0.08838834764831845f;
          if (i & 1) vp[i >> 1] |= ((unsigned)rv[i]) << 16; else vp[i >> 1] = (unsigned)rv[i];
        }
        if (hf) {
#pragma unroll
          for (int i = 0; i < 16; ++i) {
            const float f = lbk + (1.f - lbk) * sigmoidf_(bf2f(rf[i]));
            kv[i] = 1.f - f;
            run *= f; ef[i] = run;
          }
        } else {
#pragma unroll
          for (int i = 15; i >= 0; --i) {
            const float f = lbk + (1.f - lbk) * sigmoidf_(bf2f(rf[i]));
            kv[i] = 1.f - f;
            ef[i] = run; run *= f;
          }
        }
        TOT[hf * 128 + kk] = run;
        {
          const int cn = (c + 1 < nchunk) ? c + 1 : c;
          HG_GLOAD(cn)
        }
        __builtin_amdgcn_sched_barrier(0);
        __syncthreads();
        {
          const float F0 = TOT[kk], F1 = TOT[128 + kk];
          unsigned ke[8];
#pragma unroll
          for (int i = 0; i < 16; ++i) {
            const int tl = hf * 16 + i;
            const float inv = frcp(ef[i]);
            const float eq = hf ? ef[i] : inv;
            const float ek = hf ? inv : ef[i];
            const float ee = ek * F1;
            *(u16*)(QT + tl * QROW + kk * 2) = f2bf(qv[i] * eq);
            *(u16*)(KT + tl * QROW + kk * 2) = f2bf(kv[i] * ek);
            const float ken = kv[i] * ee;
            if (i & 1) ke[i >> 1] = pk2(__uint_as_float(ke[i >> 1]), ken);
            else ke[i >> 1] = __float_as_uint(ken);
          }
          *(uint4*)(KE + kk * EROW + hf * 32) = make_uint4(ke[0], ke[1], ke[2], ke[3]);
          *(uint4*)(KE + kk * EROW + hf * 32 + 16) = make_uint4(ke[4], ke[5], ke[6], ke[7]);
          *(uint4*)(VT + kk * EROW + hf * 32) = make_uint4(vp[0], vp[1], vp[2], vp[3]);
          *(uint4*)(VT + kk * EROW + hf * 32 + 16) = make_uint4(vp[4], vp[5], vp[6], vp[7]);
          if (hf == 0) { EMID[kk] = F0; DEC[kk] = F0 * F1; }
        }
        __syncthreads();
      } else {
        __syncthreads();
        __syncthreads();
      }
    }
#undef HG_GLOAD
  } else {
    f32x16 S[4];
    {
      const float* sp = p.state_hgrn + (((size_t)(b * 2 + l) * 2 + dir) * 4 + h) * 16384 + wave * 32 + r;
#pragma unroll
      for (int kb = 0; kb < 4; ++kb)
#pragma unroll
        for (int i = 0; i < 16; ++i) S[kb][i] = sp[(size_t)(kb * 32 + crow(i, g)) * 128];
    }
    u16* obase = dir ? (u16*)(p.ws + W_OB) : (u16*)(p.ws + W_BRANCH);
    const size_t ostride = dir ? 512 : 2048;
    __syncthreads();
    __syncthreads();
    for (int c = 0; c < nchunk; ++c) {
      char* QT = smem + (c & 1) * BUFB;
      char* KT = QT + 32 * QROW;
      char* KE = KT + 32 * QROW;
      char* VT = KE + 128 * EROW;
      float* EMID = (float*)(VT + 128 * EROW);
      float* DEC = EMID + 128;
      f32x16 oacc;
#pragma unroll
      for (int i = 0; i < 16; ++i) oacc[i] = 0.f;
#pragma unroll
      for (int kb = 0; kb < 4; ++kb) {
#pragma unroll
        for (int s = 0; s < 2; ++s) {
          const float4 e0 = *(const float4*)(EMID + kb * 32 + 16 * s + 4 * g);
          const float4 e1 = *(const float4*)(EMID + kb * 32 + 16 * s + 8 + 4 * g);
          uint4 au;
          au.x = pk2(S[kb][8 * s + 0] * e0.x, S[kb][8 * s + 1] * e0.y);
          au.y = pk2(S[kb][8 * s + 2] * e0.z, S[kb][8 * s + 3] * e0.w);
          au.z = pk2(S[kb][8 * s + 4] * e1.x, S[kb][8 * s + 5] * e1.y);
          au.w = pk2(S[kb][8 * s + 6] * e1.z, S[kb][8 * s + 7] * e1.w);
          const char* qp = QT + r * QROW + (kb * 32 + 16 * s + 4 * g) * 2;
          bf16x4 lo = *(const bf16x4*)(qp);
          bf16x4 hi = *(const bf16x4*)(qp + 16);
          oacc = MFMA32(__builtin_bit_cast(bf16x8, au), __builtin_shufflevector(lo, hi, 0, 1, 2, 3, 4, 5, 6, 7), oacc);
        }
      }
      f32x16 sacc;
#pragma unroll
      for (int i = 0; i < 16; ++i) sacc[i] = 0.f;
#pragma unroll
      for (int ks = 0; ks < 8; ++ks) {
        bf16x8 ka = *(const bf16x8*)(KT + r * QROW + (16 * ks + 8 * g) * 2);
        bf16x8 qb = *(const bf16x8*)(QT + r * QROW + (16 * ks + 8 * g) * 2);
        sacc = MFMA32(ka, qb, sacc);
      }
#pragma unroll
      for (int i = 0; i < 16; ++i) sacc[i] = (crow(i, g) <= r) ? sacc[i] : 0.f;
      __syncthreads();
#pragma unroll
      for (int s2 = 0; s2 < 2; ++s2) {
        uint4 pu;
        pu.x = pk2(sacc[8 * s2 + 0], sacc[8 * s2 + 1]); pu.y = pk2(sacc[8 * s2 + 2], sacc[8 * s2 + 3]);
        pu.z = pk2(sacc[8 * s2 + 4], sacc[8 * s2 + 5]); pu.w = pk2(sacc[8 * s2 + 6], sacc[8 * s2 + 7]);
        const char* vq = VT + (wave * 32 + r) * EROW + (16 * s2 + 4 * g) * 2;
        bf16x4 lo = *(const bf16x4*)(vq);
        bf16x4 hi = *(const bf16x4*)(vq + 16);
        oacc = MFMA32(__builtin_shufflevector(lo, hi, 0, 1, 2, 3, 4, 5, 6, 7), __builtin_bit_cast(bf16x8, pu), oacc);
      }
      {
        int sp_ = c * 32 + r;
        int tok_ = dir ? (T - 1 - sp_) : sp_;
        u16* op = obase + (size_t)(rowbase + tok_) * ostride + h * 128 + wave * 32 + 4 * g;
#pragma unroll
        for (int q4 = 0; q4 < 4; ++q4)
          *(uint2*)(op + 8 * q4) = pk4(oacc[4 * q4 + 0], oacc[4 * q4 + 1], oacc[4 * q4 + 2], oacc[4 * q4 + 3]);
      }
#pragma unroll
      for (int kb = 0; kb < 4; ++kb) {
#pragma unroll
        for (int q4 = 0; q4 < 4; ++q4) {
          const float4 d4 = *(const float4*)(DEC + kb * 32 + 8 * q4 + 4 * g);
          S[kb][4 * q4 + 0] *= d4.x; S[kb][4 * q4 + 1] *= d4.y; S[kb][4 * q4 + 2] *= d4.z; S[kb][4 * q4 + 3] *= d4.w;
        }
#pragma unroll
        for (int s = 0; s < 2; ++s) {
          bf16x8 ka = *(const bf16x8*)(KE + (kb * 32 + r) * EROW + (16 * s + 8 * g) * 2);
          bf16x8 vb = *(const bf16x8*)(VT + (wave * 32 + r) * EROW + (16 * s + 8 * g) * 2);
          S[kb] = MFMA32(ka, vb, S[kb]);
        }
      }
      __syncthreads();
    }
  }
}

DI void hgpost_job(const Params& p_in, int l, int job) {
  Params p = p_in; launder_params(p);
  const int tid = tidx(), li = tid & 31;
  const float4 gn = *(const float4*)(p.hg_gain + l * 128 + li * 4);
  const u16* pr = (const u16*)(p.ws + W_PROJ);
  u16* br = (u16*)(p.ws + W_BRANCH);
  const u16* ob = (const u16*)(p.ws + W_OB);
  for (int pass = 0; pass < 16; ++pass) {
    int vec = pass * 8 + (tid >> 5);
    int row = job * 32 + (vec >> 2), h = vec & 3;
    float a[4], bb[4], gt[4];
    unpack4(*(const uint2*)(br + (size_t)row * 2048 + h * 128 + li * 4), a);
    unpack4(*(const uint2*)(ob + (size_t)row * 512 + h * 128 + li * 4), bb);
    unpack4(*(const uint2*)(pr + (size_t)row * PW + C_HG + h * 128 + li * 4), gt);
    float o0 = a[0] + bb[0], o1 = a[1] + bb[1], o2 = a[2] + bb[2], o3 = a[3] + bb[3];
    float ss = o0 * o0 + o1 * o1 + o2 * o2 + o3 * o3;
#pragma unroll
    for (int o = 16; o >= 1; o >>= 1) ss += shx(ss, o);
    float rstd = rsqrtf(ss * (1.f / 128.f) + EPS);
    *(uint2*)(br + (size_t)row * 2048 + h * 128 + li * 4) =
        pk4(o0 * rstd * gn.x * siluf_(gt[0]), o1 * rstd * gn.y * siluf_(gt[1]), o2 * rstd * gn.z * siluf_(gt[2]),
            o3 * rstd * gn.w * siluf_(gt[3]));
  }
}

DI void inproj_tile(const Params& p_in, int idx, char* smem) {
  Params p = p_in; launder_params(p);
  const int mt = idx & 63, nt = idx >> 6;
  f32x16 acc[2][2];
  zero_acc<2, 2>(acc);
  gemm_core<2, 2>((const u16*)(p.ws + W_H) + (size_t)mt * 128 * 1024, 1024, (const u16*)(p.ws + W_IN) + (size_t)nt * 128 * 1024, 1024,
                  PW - nt * 128, 1024, acc, smem);
  u16* pr = (u16*)(p.ws + W_PROJ);
  EPI_LOOP(2, 2, acc, {
    int col = nt * 128 + ec;
    if (col < PW) {
      size_t o = (size_t)(mt * 128 + er) * PW + col;
      pr[o] = f2bf(v0); pr[o + PW] = f2bf(v1); pr[o + 2 * PW] = f2bf(v2); pr[o + 3 * PW] = f2bf(v3);
    }
  })
}

DI void qb_tile(const Params& p_in, int l, int idx, char* smem) {
  Params p = p_in; launder_params(p);
  const size_t wo = l ? W_SET2 : 0;
  const int mt = idx & 63, nt = idx >> 6;
  f32x16 acc[2][2];
  zero_acc<2, 2>(acc);
  gemm_core<2, 2>((const u16*)(p.ws + W_AQ) + (size_t)mt * 128 * 256, 256, (const u16*)(p.ws + wo + W_QB) + (size_t)nt * 128 * 256, 256, 128, 256,
                  acc, smem);
  u16* qd = (u16*)(p.ws + W_QD);
  EPI_LOOP(2, 2, acc, {
    size_t o = (size_t)(mt * 128 + er) * 768 + nt * 128 + ec;
    qd[o] = f2bf(v0); qd[o + 768] = f2bf(v1); qd[o + 2 * 768] = f2bf(v2); qd[o + 3 * 768] = f2bf(v3);
  })
}

DI void kvb_tile(const Params& p_in, int l, int idx, char* smem) {
  Params p = p_in; launder_params(p);
  const size_t wo = l ? W_SET2 : 0;
  const int mt = idx % 80, h = idx / 80;
  f32x16 acc[2][2];
  zero_acc<2, 2>(acc);
  gemm_core<2, 2>((const u16*)(p.ws + W_ACKV) + (size_t)mt * 128 * 128, 128, (const u16*)(p.ws + wo + W_KVB) + (size_t)h * 128 * 128, 128, 128, 128,
                  acc, smem);
  const int r0 = mt * 128;
  u16* kd; u16* vt; size_t vstride; int key0;
  if (r0 < NCTX) {
    int b = r0 >> 8; key0 = r0 & 255;
    kd = (u16*)(p.ws + W_KDC) + (size_t)r0 * 768;
    vt = (u16*)(p.ws + W_VDTC) + (size_t)b * 512 * 256; vstride = 256;
  } else if (r0 < NTOK) {
    int rr = r0 - NCTX; int b = rr >> 10; key0 = 512 + (rr & 1023);
    kd = (u16*)(p.ws + W_KDL) + ((size_t)b * 1536 + key0) * 768;
    vt = (u16*)(p.ws + W_VDTL) + (size_t)b * 512 * 1536; vstride = 1536;
  } else {
    int rr = r0 - NTOK; int b = rr >> 9; key0 = rr & 511;
    kd = (u16*)(p.ws + W_KDL) + ((size_t)b * 1536 + key0) * 768;
    vt = (u16*)(p.ws + W_VDTL) + (size_t)b * 512 * 1536; vstride = 1536;
  }
  EPI_LOOP(2, 2, acc, {
    if (ec < 64) {
      size_t o = (size_t)er * 768 + h * 96 + ec;
      kd[o] = f2bf(v0); kd[o + 768] = f2bf(v1); kd[o + 2 * 768] = f2bf(v2); kd[o + 3 * 768] = f2bf(v3);
    } else {
      *(uint2*)(vt + (size_t)(h * 64 + ec - 64) * vstride + key0 + er) = pk4(v0, v1, v2, v3);
    }
  })
}

DI void merge_tile(const Params& p_in, int idx, char* smem) {
  Params p = p_in; launder_params(p);
  const int mt = idx & 63, nt = idx >> 6;
  f32x16 tot[2][1], bo[2][1], gg[2][1];
  zero_acc<2, 1>(tot);
#pragma unroll 1
  for (int n = 0; n < 4; ++n) {
    zero_acc<2, 1>(bo);
    zero_acc<2, 1>(gg);
    gemm_core<2, 1>((const u16*)(p.ws + W_BRANCH) + (size_t)mt * 128 * 2048 + n * 512, 2048,
                    (const u16*)(p.ws + W_BR) + ((size_t)n * 1024 + nt * 64) * 512, 512, 64, 512, bo, smem);
    gemm_core<2, 1>((const u16*)(p.ws + W_H) + (size_t)mt * 128 * 1024, 1024,
                    (const u16*)(p.ws + W_IN) + ((size_t)C_GATES + n * 1024 + nt * 64) * 1024, 1024, 64, 1024, gg, smem);
#pragma unroll
    for (int mb = 0; mb < 2; ++mb)
#pragma unroll
      for (int i = 0; i < 16; ++i) tot[mb][0][i] += sigmoidf_(gg[mb][0][i]) * bo[mb][0][i];
  }
  u16* mg = (u16*)(p.ws + W_MERGED);
  EPI_LOOP(2, 1, tot, {
    size_t o = (size_t)(mt * 128 + er) * 1024 + nt * 64 + ec;
    mg[o] = f2bf(v0); mg[o + 1024] = f2bf(v1); mg[o + 2048] = f2bf(v2); mg[o + 3072] = f2bf(v3);
  })
}

DI void resid_tile(const Params& p_in, int l, int idx, const u16* A, int lda, const u16* Wt, int K, int which, char* smem) {
  Params p = p_in; launder_params(p);
  const int mt = idx & 63, nt = idx >> 6;
  f32x16 acc[2][2];
  zero_acc<2, 2>(acc);
  gemm_core<2, 2>(A + (size_t)mt * 128 * lda, lda, Wt + (size_t)nt * 128 * K, K, 128, K, acc, smem);
  const int cond = cond_of_row(mt * 128);
  const float* gt = (const float*)(p.ws + W_MOD) + (size_t)(l * 5 + cond) * 6144 + which * 1024;
  EPI_LOOP(2, 2, acc, {
    int col = nt * 128 + ec;
    float gv = gt[col];
    float* xp = p.out + (size_t)(mt * 128 + er) * 1024 + col;
    xp[0] += gv * v0; xp[1024] += gv * v1; xp[2048] += gv * v2; xp[3072] += gv * v3;
  })
}

DI void ffn1_tile(const Params& p_in, int idx, char* smem) {
  Params p = p_in; launder_params(p);
  const int mt = idx & 63, nt = idx >> 6;
  f32x16 acc[2][2];
  zero_acc<2, 2>(acc);
  gemm_core<2, 2>((const u16*)(p.ws + W_H) + (size_t)mt * 128 * 1024, 1024, (const u16*)(p.ws + W_FFI) + (size_t)nt * 128 * 1024, 1024, 128, 1024,
                  acc, smem);
  u16* hd = (u16*)(p.ws + W_HIDDEN);
  const int lane = tidx() & 63, wave = tidx() >> 6, wm = wave >> 1, wn = wave & 1, g = lane >> 5;
#pragma unroll
  for (int mb = 0; mb < 2; ++mb)
#pragma unroll
    for (int i = 0; i < 16; ++i) {
      float av = acc[mb][0][i], gv = acc[mb][1][i];
      int row = mt * 128 + wm * 64 + mb * 32 + crow(i, g);
      int col = (nt * 2 + wn) * 32 + (lane & 31);
      hd[(size_t)row * FFH + col] = f2bf(siluf_(gv) * av);
    }
}


DI void inproj_phase512(const Params& p_in, int l, int bid, int G, char* smem) {
  Params p = p_in; launder_params(p);
  const size_t wo = l ? W_SET2 : 0;
  u32x4 ra[4], rb[4];
  bool pre = false;
  for (int idx = bid; idx < 32 * 21; idx += G) {
    const int mt = idx & 31, nt = idx >> 5;
    const int idn = idx + G;
    const bool has_next = idn < 32 * 21;
    const int mtn = has_next ? (idn & 31) : mt, ntn = has_next ? (idn >> 5) : nt;
    const GDesc512<4> c = make_gdesc<4>((const u16*)(p.ws + W_H) + (size_t)mt * 256 * 1024, 1024,
                                        (const u16*)(p.ws + wo + W_IN) + (size_t)nt * 256 * 1024, 1024, PW - nt * 256, 1024);
    const GDesc512<4> n = make_gdesc<4>((const u16*)(p.ws + W_H) + (size_t)mtn * 256 * 1024, 1024,
                                        (const u16*)(p.ws + wo + W_IN) + (size_t)ntn * 256 * 1024, 1024, PW - ntn * 256, 1024);
    f32x16 acc[2][4];
    zero_acc<2, 4>(acc);
    gemm512_chain<2, 4>(c, n, has_next, pre, ra, rb, acc, smem);
    pre = has_next;
    u16* pr = (u16*)(p.ws + W_PROJ);
    EPI512(2, 4, acc, {
      int col = nt * 256 + ec;
      if (col < PW) {
        size_t o = (size_t)(mt * 256 + er) * PW + col;
        pr[o] = f2bf(v0); pr[o + PW] = f2bf(v1); pr[o + 2 * PW] = f2bf(v2); pr[o + 3 * PW] = f2bf(v3);
      }
    })
  }
}

DI void ffn1_phase512(const Params& p_in, int l, int bid, int G, char* smem) {
  Params p = p_in; launder_params(p);
  const size_t wo = l ? W_SET2 : 0;
  u32x4 ra[4], rb[4];
  bool pre = false;
  for (int idx = bid; idx < 32 * 22; idx += G) {
    const int mt = idx & 31, nt = idx >> 5;
    const int idn = idx + G;
    const bool has_next = idn < 32 * 22;
    const int mtn = has_next ? (idn & 31) : mt, ntn = has_next ? (idn >> 5) : nt;
    const GDesc512<4> c = make_gdesc<4>((const u16*)(p.ws + W_H) + (size_t)mt * 256 * 1024, 1024,
                                        (const u16*)(p.ws + wo + W_FFI) + (size_t)nt * 256 * 1024, 1024, 256, 1024);
    const GDesc512<4> n = make_gdesc<4>((const u16*)(p.ws + W_H) + (size_t)mtn * 256 * 1024, 1024,
                                        (const u16*)(p.ws + wo + W_FFI) + (size_t)ntn * 256 * 1024, 1024, 256, 1024);
    f32x16 acc[2][4];
    zero_acc<2, 4>(acc);
    gemm512_chain<2, 4>(c, n, has_next, pre, ra, rb, acc, smem);
    pre = has_next;
    u16* hd = (u16*)(p.ws + W_HIDDEN);
    const int t5 = tidx512();
    const int lane = t5 & 63, wave = t5 >> 6, wm = wave >> 1, wn = wave & 1, g = lane >> 5;
#pragma unroll
    for (int mb = 0; mb < 2; ++mb)
#pragma unroll
      for (int pr2 = 0; pr2 < 2; ++pr2)
#pragma unroll
        for (int i = 0; i < 16; ++i) {
          float av = acc[mb][2 * pr2][i], gv = acc[mb][2 * pr2 + 1][i];
          int row = mt * 256 + wm * 64 + mb * 32 + crow(i, g);
          int col = (nt * 4 + wn * 2 + pr2) * 32 + (lane & 31);
          hd[(size_t)row * FFH + col] = f2bf(siluf_(gv) * av);
        }
  }
}

DI void resid512(const Params& p_in, int l, int idx, const u16* A, int lda, const u16* Wt, int K, int which, char* smem) {
  Params p = p_in; launder_params(p);
  const int mt = idx & 31, nt = idx >> 5;
  f32x16 acc[2][2];
  zero_acc<2, 2>(acc);
  gemm512_core<2, 2>(A + (size_t)mt * 256 * lda, lda, Wt + (size_t)nt * 128 * K, K, 128, K, acc, smem);
  const int cond = cond_of_row(mt * 256);
  const float* gt = (const float*)(p.ws + W_MOD) + (size_t)(l * 5 + cond) * 6144 + which * 1024;
  EPI512(2, 2, acc, {
    int col = nt * 128 + ec;
    float gv = gt[col];
    float* xp = p.out + (size_t)(mt * 256 + er) * 1024 + col;
    xp[0] += gv * v0; xp[1024] += gv * v1; xp[2048] += gv * v2; xp[3072] += gv * v3;
  })
}

DI void merge512(const Params& p_in, int l, int idx, char* smem) {
  Params p = p_in; launder_params(p);
  const size_t wo = l ? W_SET2 : 0;
  const int mt = idx & 31, nt = idx >> 5;
  unsigned totp[2][2][8], sgp[2][2][8];
#pragma unroll
  for (int mb = 0; mb < 2; ++mb)
#pragma unroll
    for (int nb = 0; nb < 2; ++nb)
#pragma unroll
      for (int i = 0; i < 8; ++i) totp[mb][nb][i] = 0u;
  u32x4 ra[4], rb[2];
  const u16* Hrow = (const u16*)(p.ws + W_H) + (size_t)mt * 256 * 1024;
  const u16* Brow = (const u16*)(p.ws + W_BRANCH) + (size_t)mt * 256 * 2048;
  const u16* Wg = (const u16*)(p.ws + wo + W_IN) + ((size_t)C_GATES + nt * 128) * 1024;
  const u16* Wb = (const u16*)(p.ws + wo + W_BR) + (size_t)(nt * 128) * 512;
#pragma unroll 1
  for (int n = 0; n < 4; ++n) {
    const GDesc512<2> dg = make_gdesc<2>(Hrow, 1024, Wg + (size_t)n * 1024 * 1024, 1024, 128, 1024);
    const GDesc512<2> db = make_gdesc<2>(Brow + n * 512, 2048, Wb + (size_t)n * 1024 * 512, 512, 128, 512);
    const int n1 = n < 3 ? n + 1 : n;
    const GDesc512<2> dg1 = make_gdesc<2>(Hrow, 1024, Wg + (size_t)n1 * 1024 * 1024, 1024, 128, 1024);
    {
      f32x16 gg[2][2];
      zero_acc<2, 2>(gg);
      gemm512_chain<2, 2>(dg, db, true, n > 0, ra, rb, gg, smem);
#pragma unroll
      for (int mb = 0; mb < 2; ++mb)
#pragma unroll
        for (int nb = 0; nb < 2; ++nb)
#pragma unroll
          for (int i = 0; i < 8; ++i) sgp[mb][nb][i] = pk2(sigmoidf_(gg[mb][nb][2 * i]), sigmoidf_(gg[mb][nb][2 * i + 1]));
    }
    {
      f32x16 bo[2][2];
      zero_acc<2, 2>(bo);
      gemm512_chain<2, 2>(db, dg1, n < 3, true, ra, rb, bo, smem);
#pragma unroll
      for (int mb = 0; mb < 2; ++mb)
#pragma unroll
        for (int nb = 0; nb < 2; ++nb)
#pragma unroll
          for (int i = 0; i < 8; ++i) {
            const unsigned t = totp[mb][nb][i], g2 = sgp[mb][nb][i];
            const float lo = __uint_as_float(t << 16) + __uint_as_float(g2 << 16) * bo[mb][nb][2 * i];
            const float hi = __uint_as_float(t & 0xffff0000u) + __uint_as_float(g2 & 0xffff0000u) * bo[mb][nb][2 * i + 1];
            totp[mb][nb][i] = pk2(lo, hi);
          }
    }
  }
  u16* mg = (u16*)(p.ws + W_MERGED);
  {
    const int t5 = tidx512();
    const int lane = t5 & 63, wave = t5 >> 6, wm = wave >> 1, wn = wave & 1, g = lane >> 5;
#pragma unroll
    for (int mb = 0; mb < 2; ++mb)
#pragma unroll
      for (int nb = 0; nb < 2; ++nb)
#pragma unroll
        for (int i = 0; i < 8; ++i) {
          const int row = mt * 256 + wm * 64 + mb * 32 + crow(2 * i, g);
          const int col = nt * 128 + wn * 64 + nb * 32 + (lane & 31);
          const unsigned t = totp[mb][nb][i];
          mg[(size_t)row * 1024 + col] = (u16)(t & 0xffffu);
          mg[(size_t)(row + 1) * 1024 + col] = (u16)(t >> 16);
        }
  }
}


constexpr int NWCONV = 16 * 37 + 16 * 22 + 44 * 4 + 4 * 8 * 4 + 16 * 4 + 4 * 3 + 2 * 4;
DI void wconv_job(const Params& p_in, int l, int j, char* sm) {
  Params p = p_in; launder_params(p);
  char* wb = p.ws + (l ? W_SET2 : 0);
  const int e0 = 16 * 37, e1 = e0 + 16 * 22, e2 = e1 + 44 * 4, e3 = e2 + 4 * 8 * 4, e4 = e3 + 16 * 4, e5 = e4 + 4 * 3;
  if (j < e0) {
    wtrans_tile(p.w_in + (size_t)l * 1024 * INW, 1024, INW, j / 37, j % 37, (u16*)(wb + W_IN), false, sm);
  } else if (j < e1) {
    int t = j - e0;
    wtrans_tile(p.w_ffn_in + (size_t)l * 1024 * 5632, 1024, 5632, t / 22, t % 22, (u16*)(wb + W_FFI), true, sm);
  } else if (j < e2) {
    int t = j - e1;
    wtrans_tile(p.w_ffn_out + (size_t)l * FFH * 1024, FFH, 1024, t >> 2, t & 3, (u16*)(wb + W_FFO), false, sm);
  } else if (j < e3) {
    int t = j - e2;
    int n = t >> 5, tt = t & 31;
    wtrans_tile(p.w_branch + ((size_t)l * 4 + n) * 512 * 1024, 512, 1024, tt >> 2, tt & 3, (u16*)(wb + W_BR) + (size_t)n * 1024 * 512, false, sm);
  } else if (j < e4) {
    int t = j - e3;
    wtrans_tile(p.w_out + (size_t)l * 1024 * 1024, 1024, 1024, t >> 2, t & 3, (u16*)(wb + W_OUT), false, sm);
  } else if (j < e5) {
    int t = j - e4;
    wtrans_tile(p.ml_w_q_b + (size_t)l * 256 * 768, 256, 768, t / 3, t % 3, (u16*)(wb + W_QB), false, sm);
  } else {
    int t = j - e5;
    wtrans_tile(p.ml_w_kv_b + (size_t)l * 128 * 1024, 128, 1024, t >> 2, t & 3, (u16*)(wb + W_KVB), false, sm);
  }
}

#define XB_TMO      128
#define XB_XCNT(j)  (256  + 64 * (j))
#define XB_XSUB(j)  (1280 + 64 * (j))
#define XB_XGEN(j)  (2304 + 64 * (j))
#define XB_TOP      3328
#define XB_TOPGEN   3392
#define XCD_BAR_WORDS 3456
#define XB_SPIN_CAP (1u << 18)
#define LAS __attribute__((address_space(3)))
DI unsigned xb_ld(unsigned* p) { return __hip_atomic_load(p, __ATOMIC_RELAXED, __HIP_MEMORY_SCOPE_AGENT); }
DI unsigned xb_add(unsigned* p, unsigned v) { return __hip_atomic_fetch_add(p, v, __ATOMIC_RELAXED, __HIP_MEMORY_SCOPE_AGENT); }
DI unsigned xb_xcc_id() { return (unsigned)__builtin_amdgcn_s_getreg((3 << 11) | 20) & 0xFu; }
#define XB_SPIN(cond, bar) do { unsigned _sp = 0; while (cond) { __builtin_amdgcn_s_sleep(1); \
    if ((++_sp & 255u) == 0u) { if (xb_ld(&(bar)[XB_TMO])) break; if (_sp > XB_SPIN_CAP) { atomicAdd(&(bar)[XB_TMO], 1u); break; } } } } while (0)
struct XcdBarrier { unsigned* bar; unsigned x; volatile LAS unsigned* st; };
DI XcdBarrier xcd_barrier_post(unsigned* bar, volatile LAS unsigned* st) {
  XcdBarrier b; b.bar = bar; b.x = xb_xcc_id(); b.st = st;
  if (threadIdx.x == 0) (void)xb_add(&bar[XB_XCNT(b.x)], 1u);
  return b;
}
DI void xcd_barrier_complete(unsigned* bar, unsigned x, unsigned& nloc, unsigned& nx) {
  const unsigned G = gridDim.x * gridDim.y * gridDim.z;
  unsigned sum, cnt, mine, sp = 0u;
  for (;;) {
    sum = 0u; cnt = 0u; mine = 0u;
#pragma unroll
    for (unsigned j = 0; j < 16; ++j) { const unsigned c = xb_ld(&bar[XB_XCNT(j)]); sum += c; cnt += (c > 0u) ? 1u : 0u; mine = (j == x) ? c : mine; }
    if (sum == G) break;
    __builtin_amdgcn_s_sleep(1);
    if ((++sp & 255u) == 0u) { if (xb_ld(&bar[XB_TMO])) break; if (sp > XB_SPIN_CAP) { atomicAdd(&bar[XB_TMO], 1u); break; } }
  }
  nloc = mine > 0u ? mine : 1u; nx = cnt > 0u ? cnt : 1u;
}
DI void xcd_barrier(const XcdBarrier& b) {
  asm volatile("s_waitcnt vmcnt(0)" ::: "memory");
  __syncthreads();
  if (threadIdx.x == 0) {
    unsigned* bar = b.bar;
    __builtin_amdgcn_s_waitcnt(0);
    unsigned nloc = b.st[0], nx = b.st[1];
    if (nloc == 0u) { xcd_barrier_complete(bar, b.x, nloc, nx); b.st[0] = nloc; b.st[1] = nx; }
    const unsigned old = xb_add(&bar[XB_XSUB(b.x)], 1u);
    const unsigned gen = old / nloc;
    if (old + 1u == (gen + 1u) * nloc) {
      __builtin_amdgcn_fence(__ATOMIC_RELEASE, "agent");
      asm volatile("s_waitcnt vmcnt(0)" ::: "memory");
      const unsigned og = xb_add(&bar[XB_TOP], 1u);
      const unsigned tg = og / nx;
      if (og + 1u == (tg + 1u) * nx) xb_add(&bar[XB_TOPGEN], 1u);
      else XB_SPIN(xb_ld(&bar[XB_TOPGEN]) == tg, bar);
      __builtin_amdgcn_fence(__ATOMIC_ACQUIRE, "agent");
      xb_add(&bar[XB_XGEN(b.x)], 1u);
      asm volatile("s_waitcnt vmcnt(0)" ::: "memory");
    } else {
      XB_SPIN(xb_ld(&bar[XB_XGEN(b.x)]) == gen, bar);
      __builtin_amdgcn_fence(__ATOMIC_ACQUIRE, "agent");
      asm volatile("s_waitcnt vmcnt(0)" ::: "memory");
    }
  }
  __syncthreads();
}


DI int launder_s(int x) { asm volatile("" : "+s"(x)); return x; }
#define SMH (smem + launder_s(sub) * SMEM_HALF)
#define WCONV_FILL(ci, lo, hi)                                                   \
  if (l == 0) {                                                                  \
    int* fctr_ = (int*)(p.ws + W_CTR) + (ci);                                    \
    for (;;) {                                                                   \
      if (threadIdx.x == 0) s_next = atomicAdd(fctr_, 2);                        \
      __syncthreads();                                                           \
      const int fj_ = (lo) + s_next + sub;                                       \
      __syncthreads();                                                           \
      if (fj_ >= (hi)) break;                                                    \
      wconv_job(p, 1, fj_, SMH);                                                  \
    }                                                                            \
  }

__global__ void __launch_bounds__(512, 2) fwd_megakernel(Params p) {
  cg::grid_group grid = cg::this_grid();
  __shared__ __attribute__((aligned(16))) char smem[SMEM_BYTES];
  __shared__ int s_next;
  __shared__ uint4 xb_words;
  const int G = gridDim.x, bid = blockIdx.x;
  const int sub = __builtin_amdgcn_readfirstlane((int)(threadIdx.x >> 8));
  if (threadIdx.x == 0) xb_words = make_uint4(0u, 0u, 0u, 0u);
  __syncthreads();
  const XcdBarrier xb = xcd_barrier_post((unsigned*)(p.ws + W_BAR), (volatile LAS unsigned*)&xb_words);

  for (int l = 0; l < 2; ++l) {
    if (l == 0) {
      const int q0 = 192, q1 = q0 + 64, q2 = q1 + NWCONV, q3 = q2 + 18;
      int* ctr = (int*)(p.ws + W_CTR) + 14;
      for (;;) {
        if (threadIdx.x == 0) s_next = atomicAdd(ctr, 2);
        __syncthreads();
        const int j = s_next + sub;
        __syncthreads();
        if (j >= q3) break;
        if (j < q0) adaln_job(p, j / 96, j % 96, SMH);
        else if (j < q1) cache_job(p, 0, j - q0, SMH);
        else if (j < q2) wconv_job(p, 0, j - q1, SMH);
        else misc_job(p, j - q2);
      }
    } else {
      for (int j0 = bid * 2; j0 < 64 + 2048; j0 += 2 * G) {
        const int j = j0 + sub;
        if (j < 64) cache_job(p, 1, j, SMH);
        else norm_job(p, 1, 0, j - 64, false);
      }
    }
    if (p.ws == nullptr) grid.sync();
    xcd_barrier(xb);
    if (l == 0) {
      for (int j0 = bid * 2; j0 < 2048; j0 += 2 * G) norm_job(p, 0, 0, j0 + sub, true);
      xcd_barrier(xb);
    }
    inproj_phase512(p, l, bid, G, smem);
    WCONV_FILL(10, 0, 340)
    xcd_barrier(xb);
    for (int j0 = bid * 2; j0 < 512; j0 += 2 * G) prep_job(p, l, ((j0 >> 2) << 1) + sub, (j0 >> 1) & 1, SMH);
    xcd_barrier(xb);
    {
      const int a0 = 64, a1 = a0 + 256, a2 = a1 + 256, a3 = a2 + 128, a4 = a3 + 640, a5 = a4 + 384, a6 = a5 + 0, a7 = a6 + 0;
      int* ctr = (int*)(p.ws + W_CTR) + l * 2;
      for (;;) {
        if (threadIdx.x == 0) s_next = atomicAdd(ctr, 2);
        __syncthreads();
        const int j = s_next + sub;
        __syncthreads();
        if (j >= a7) break;
        if (j < a0) hgrn_lat_pc(p, l, j >> 1, sub, smem);
        else if (j < a1) gqa_item(p, 1, j - a0, SMH);
        else if (j < a2) na_lat_item(p, l, j - a1, SMH);
        else if (j < a3) hgrn_mfma_item(p, l, 0, j - a2, SMH);
        else if (j < a4) kvb_tile(p, l, j - a3, SMH);
        else if (j < a5) qb_tile(p, l, j - a4, SMH);
        else if (j < a6) gqa_item(p, 0, j - a5, SMH);
        else na_ctx_item(p, j - a6, SMH);
      }
      WCONV_FILL(11, 340, 760)
    }
    xcd_barrier(xb);
    {
      int* ctr = (int*)(p.ws + W_CTR) + l * 2 + 1;
      for (;;) {
        if (threadIdx.x == 0) s_next = atomicAdd(ctr, 2);
        __syncthreads();
        const int j = s_next + sub;
        __syncthreads();
        if (j >= 1280) break;
        if (j < 256) mla_item(p, 1, j, SMH);
        else if (j < 512) hgpost_job(p, l, j - 256);
        else if (j < 768) mla_item(p, 0, j - 512, SMH);
        else if (j < 1024) gqa_item(p, 0, j - 768, SMH);
        else na_ctx_item(p, j - 1024, SMH);
      }
      WCONV_FILL(12, 760, 1100)
    }
    xcd_barrier(xb);
    for (int j = bid; j < 256; j += G) merge512(p, l, j, smem);
    xcd_barrier(xb);
    for (int j = bid; j < 256; j += G)
      resid512(p, l, j, (const u16*)(p.ws + W_MERGED), 1024, (const u16*)(p.ws + (l ? W_SET2 : 0) + W_OUT), 1024, 2, smem);
    xcd_barrier(xb);
    for (int j0 = bid * 2; j0 < 2048; j0 += 2 * G) norm_job(p, l, 1, j0 + sub, false);
    xcd_barrier(xb);
    ffn1_phase512(p, l, bid, G, smem);
    WCONV_FILL(13, 1100, NWCONV)
    xcd_barrier(xb);
    for (int j = bid; j < 256; j += G)
      resid512(p, l, j, (const u16*)(p.ws + W_HIDDEN), FFH, (const u16*)(p.ws + (l ? W_SET2 : 0) + W_FFO), FFH, 5, smem);
    xcd_barrier(xb);
  }
  for (int j0 = bid * 2; j0 < 2048; j0 += 2 * G) final_norm_job(p, j0 + sub);
}

extern "C" void kernel_launch(void* const* d_in, const int* in_sizes, int n_in, void* d_out, int out_size, void* d_ws,
                              size_t ws_size, hipStream_t stream) {
  static int grid_blocks = 0;
  if (!grid_blocks) {
    int dev = 0, cus = 0, per_cu = 0;
    hipGetDevice(&dev);
    hipDeviceGetAttribute(&cus, hipDeviceAttributeMultiprocessorCount, dev);
    hipOccupancyMaxActiveBlocksPerMultiprocessor(&per_cu, fwd_megakernel, 512, 0);
    per_cu = 1;
    grid_blocks = cus * per_cu;
  }
  if (ws_size < W_TOTAL) { fprintf(stderr, "workspace too small: %zu < %zu\n", ws_size, (size_t)W_END); return; }
  Params p{};
  const float** f = (const float**)&p;
  for (int i = 0; i < 28; ++i) f[i] = (const float*)d_in[i];
  p.out = (float*)d_out;
  p.ws = (char*)d_ws;
  hipMemsetAsync((char*)d_ws + W_CTR, 0, 64 + 3456 * 4, stream);
  void* args[] = {&p};
  hipError_t e = hipLaunchCooperativeKernel((void*)fwd_megakernel, dim3(grid_blocks), dim3(512), args, 0, stream);
  if (e != hipSuccess) fprintf(stderr, "cooperative launch failed: %s (grid %d)\n", hipGetErrorString(e), grid_blocks);
}
```

```cpp
#include <hip/hip_runtime.h>
#include <hip/hip_cooperative_groups.h>
#include <stdint.h>
#include <cstdio>
namespace cg = cooperative_groups;

typedef unsigned short u16;
typedef __attribute__((ext_vector_type(8))) short bf16x8;
typedef __attribute__((ext_vector_type(4))) short bf16x4;
typedef __attribute__((ext_vector_type(16))) float f32x16;
typedef __attribute__((ext_vector_type(2))) float f32x2;
typedef __attribute__((ext_vector_type(4))) float f32v4;
typedef __attribute__((ext_vector_type(4))) unsigned u32x4;
typedef __attribute__((ext_vector_type(2))) __bf16 bfx2;
#define DI __device__ __forceinline__
#define MFMA32(a, b, c) __builtin_amdgcn_mfma_f32_32x32x16_bf16((a), (b), (c), 0, 0, 0)

constexpr int D = 1024;
constexpr int NTOK = 8192;
constexpr int NCTX = 4096;
constexpr int PW = 5280;
constexpr int INW = 9376;
constexpr int FFH = 2816;
constexpr int C_HQ = 0, C_HFF = 512, C_HFB = 1024, C_HI = 1536, C_HG = 2048, C_GQ = 2560, C_GK = 3072, C_GV = 3200,
              C_NQ = 3328, C_NK = 3840, C_NV = 4352, C_MQA = 4864, C_MKVA = 5120, C_MKR = 5248, C_GATES = 5280;
constexpr float EPS = 1e-6f;
constexpr float LOG2E = 1.4426950408889634f;

constexpr size_t O_X = 0;
constexpr size_t O_STATE = 8388608;
constexpr size_t O_GQK = 12582912;
constexpr size_t O_GQV = 13631488;
constexpr size_t O_NAK = 14680064;
constexpr size_t O_NAV = 18874368;
constexpr size_t O_CKV = 23068672;
constexpr size_t O_KR = 24117248;

constexpr size_t W_IN = 0;
constexpr size_t W_FFI = W_IN + (size_t)INW * 1024 * 2;
constexpr size_t W_FFO = W_FFI + (size_t)5632 * 1024 * 2;
constexpr size_t W_BR = W_FFO + (size_t)1024 * FFH * 2;
constexpr size_t W_OUT = W_BR + (size_t)4 * 1024 * 512 * 2;
constexpr size_t W_QB = W_OUT + (size_t)1024 * 1024 * 2;
constexpr size_t W_KVB = W_QB + (size_t)768 * 256 * 2;
constexpr size_t W_MOD = W_KVB + (size_t)1024 * 128 * 2;
constexpr size_t W_LBV = W_MOD + (size_t)2 * 5 * 6144 * 4;
constexpr size_t W_ROPEB = W_LBV + (size_t)2 * 2 * 512 * 4;
constexpr size_t W_ROPED = W_ROPEB + (size_t)1024 * 32 * 8;
constexpr size_t W_PROJ = W_ROPED + (size_t)1024 * 16 * 8;
constexpr size_t W_H = W_PROJ + (size_t)NTOK * PW * 2;
constexpr size_t W_BRANCH = W_H + (size_t)NTOK * 1024 * 2;
constexpr size_t W_OB = W_BRANCH + (size_t)NTOK * 2048 * 2;
constexpr size_t W_QBF = W_OB + (size_t)NTOK * 512 * 2;
constexpr size_t W_KBC = W_QBF + (size_t)NTOK * 512 * 2;
constexpr size_t W_KBL = W_KBC + (size_t)4096 * 128 * 2;
constexpr size_t W_VBTC = W_KBL + (size_t)4 * 1536 * 128 * 2;
constexpr size_t W_VBTL = W_VBTC + (size_t)16 * 128 * 256 * 2;
constexpr size_t W_NKC = W_VBTL + (size_t)4 * 128 * 1536 * 2;
constexpr size_t W_NVTC = W_NKC + (size_t)4 * 512 * 512 * 2;
constexpr size_t W_NVTL = W_NVTC + (size_t)16 * 512 * 256 * 2;
constexpr size_t W_AQ = W_NVTL + (size_t)4 * 512 * 1536 * 2;
constexpr size_t W_ACKV = W_AQ + (size_t)NTOK * 256 * 2;
constexpr size_t W_QD = W_ACKV + (size_t)10240 * 128 * 2;
constexpr size_t W_KDC = W_QD + (size_t)NTOK * 768 * 2;
constexpr size_t W_KDL = W_KDC + (size_t)4096 * 768 * 2;
constexpr size_t W_VDTC = W_KDL + (size_t)4 * 1536 * 768 * 2;
constexpr size_t W_VDTL = W_VDTC + (size_t)16 * 512 * 256 * 2;
constexpr size_t W_END = W_VDTL + (size_t)4 * 512 * 1536 * 2;
constexpr size_t W_CTR = W_END;
constexpr size_t W_BAR = W_END + 64;
constexpr size_t W_SET2 = W_BAR + 3456 * 4 + 64;
constexpr size_t W_TOTAL = W_SET2 + W_MOD;
constexpr size_t W_MERGED = W_OB;
constexpr size_t W_HIDDEN = W_PROJ;

constexpr int SMEM_HALF = 73728;
constexpr int SMEM_BYTES = 2 * SMEM_HALF;

struct Params {
  const float *x_prompt, *x_sample, *state_hgrn, *cgk, *cgv, *cnk, *cnv, *cckv, *ckr, *c, *c_ctx, *w_ada, *b_ada, *w_in,
      *lb_logits, *hg_gain, *gq_q_gain, *gq_k_gain, *na_rpb, *ml_q_a_gain, *ml_kv_a_gain, *ml_w_q_b, *ml_w_kv_b, *w_branch,
      *w_out, *w_ffn_in, *w_ffn_out, *final_gain;
  float* out;
  char* ws;
};

DI int tidx() { int t = threadIdx.x & 255; asm volatile("" : "+v"(t)); return t; }
DI int tidx512() { int t = threadIdx.x; asm volatile("" : "+v"(t)); return t; }
DI void launder_params(Params& q) { size_t z = 0; asm volatile("" : "+s"(z)); q.ws += z; q.out += z; }

DI float bf2f(u16 b) { return __uint_as_float(((unsigned)b) << 16); }
DI unsigned pk2(float a, float b) {
  f32x2 v = {a, b};
  bfx2 r = __builtin_convertvector(v, bfx2);
  return __builtin_bit_cast(unsigned, r);
}
DI u16 f2bf(float a) { return (u16)(pk2(a, 0.f) & 0xffffu); }
DI uint2 pk4(float a, float b, float c, float d) { uint2 r; r.x = pk2(a, b); r.y = pk2(c, d); return r; }
DI float frcp(float x) { return __builtin_amdgcn_rcpf(x); }
DI float sigmoidf_(float x) { return frcp(1.f + __expf(-x)); }
DI float siluf_(float x) { return x * frcp(1.f + __expf(-x)); }
DI void unpack4(uint2 u, float* f) {
  f[0] = __uint_as_float(u.x << 16); f[1] = __uint_as_float(u.x & 0xffff0000u);
  f[2] = __uint_as_float(u.y << 16); f[3] = __uint_as_float(u.y & 0xffff0000u);
}
DI void unpack8(uint4 u, float* f) {
  f[0] = __uint_as_float(u.x << 16); f[1] = __uint_as_float(u.x & 0xffff0000u);
  f[2] = __uint_as_float(u.y << 16); f[3] = __uint_as_float(u.y & 0xffff0000u);
  f[4] = __uint_as_float(u.z << 16); f[5] = __uint_as_float(u.z & 0xffff0000u);
  f[6] = __uint_as_float(u.w << 16); f[7] = __uint_as_float(u.w & 0xffff0000u);
}

DI float shx(float v, int m) {
  int iv = __float_as_int(v), r;
  switch (m) {
    case 1:  r = __builtin_amdgcn_ds_swizzle(iv, 0x041f); break;
    case 2:  r = __builtin_amdgcn_ds_swizzle(iv, 0x081f); break;
    case 4:  r = __builtin_amdgcn_ds_swizzle(iv, 0x101f); break;
    case 8:  r = __builtin_amdgcn_ds_swizzle(iv, 0x201f); break;
    case 16: r = __builtin_amdgcn_ds_swizzle(iv, 0x401f); break;
    default: {
      int lid = __builtin_amdgcn_mbcnt_hi(~0u, __builtin_amdgcn_mbcnt_lo(~0u, 0u));
      asm volatile("" : "+v"(lid));
      r = __builtin_amdgcn_ds_bpermute((lid ^ 32) << 2, iv);
    } break;
  }
  return __int_as_float(r);
}
DI float4 ldnt4(const float* p) { f32v4 t = __builtin_nontemporal_load((const f32v4*)p); return make_float4(t[0], t[1], t[2], t[3]); }
DI void stnt4(float* p, float4 v) { f32v4 t = {v.x, v.y, v.z, v.w}; __builtin_nontemporal_store(t, (f32v4*)p); }
DI int crow(int i, int g) { return (i & 3) + 8 * (i >> 2) + 4 * g; }
DI int cond_of_row(int row) { return row < NCTX ? 0 : 1 + ((row - NCTX) >> 10); }

template <int MB, int NB>
DI void gemm_core(const u16* __restrict__ A, int lda, const u16* __restrict__ B, int ldb, int nvalid, int K,
                  f32x16 (&acc)[MB][NB], char* smem) {
  constexpr int BM = 64 * MB, BN = 64 * NB;
  constexpr int LROW = 144;
  constexpr int ACH = MB * 2, BCH = NB * 2;
  char* As = smem;
  char* Bs = smem + 2 * BM * LROW;
  const int tid = tidx(), lane = tid & 63, wave = tid >> 6, wm = wave >> 1, wn = wave & 1;
  u32x4 ra0[ACH], rb0[BCH], ra1[ACH], rb1[BCH];
  const int crow_ = tid >> 3, ckc = tid & 7;
  const u16* ap[ACH];
  const u16* bp[BCH];
#pragma unroll
  for (int i = 0; i < ACH; ++i) ap[i] = A + (size_t)(crow_ + 32 * i) * lda + ckc * 8;
#pragma unroll
  for (int i = 0; i < BCH; ++i) {
    int r = crow_ + 32 * i;
    r = r < nvalid ? r : nvalid - 1;
    bp[i] = B + (size_t)r * ldb + ckc * 8;
  }
  int nk = K >> 6;
  asm volatile("" : "+s"(nk));
  char* const as_w = As + crow_ * LROW + ckc * 16;
  char* const bs_w = Bs + crow_ * LROW + ckc * 16;
  const char* const a_rd = As + (wm * 32 * MB + (lane & 31)) * LROW + (lane >> 5) * 16;
  const char* const b_rd = Bs + (wn * 32 * NB + (lane & 31)) * LROW + (lane >> 5) * 16;
#define GLOAD(RA, RB, K0)                                                               \
  {                                                                                     \
    _Pragma("unroll") for (int i = 0; i < ACH; ++i) RA[i] = *(const u32x4*)(ap[i] + (K0)); \
    _Pragma("unroll") for (int i = 0; i < BCH; ++i) RB[i] = *(const u32x4*)(bp[i] + (K0)); \
  }
#define SSTORE(RA, RB, BUF)                                                                              \
  {                                                                                                      \
    _Pragma("unroll") for (int i = 0; i < ACH; ++i) *(u32x4*)(as_w + ((BUF) * BM + 32 * i) * LROW) = RA[i]; \
    _Pragma("unroll") for (int i = 0; i < BCH; ++i) *(u32x4*)(bs_w + ((BUF) * BN + 32 * i) * LROW) = RB[i]; \
  }
#define COMPUTE(BUF)                                                                                  \
  {                                                                                                   \
    bf16x8 af[4][MB], bfr[4][NB];                                                                     \
    _Pragma("unroll") for (int s = 0; s < 4; ++s) {                                                   \
      _Pragma("unroll") for (int mb = 0; mb < MB; ++mb)                                               \
        af[s][mb] = *(const bf16x8*)(a_rd + ((BUF) * BM + mb * 32) * LROW + s * 32);                  \
      _Pragma("unroll") for (int nb = 0; nb < NB; ++nb)                                               \
        bfr[s][nb] = *(const bf16x8*)(b_rd + ((BUF) * BN + nb * 32) * LROW + s * 32);                 \
    }                                                                                                 \
    _Pragma("unroll") for (int s = 0; s < 4; ++s)                                                     \
      _Pragma("unroll") for (int mb = 0; mb < MB; ++mb)                                               \
        _Pragma("unroll") for (int nb = 0; nb < NB; ++nb)                                             \
          acc[mb][nb] = MFMA32(af[s][mb], bfr[s][nb], acc[mb][nb]);                                   \
  }
  GLOAD(ra0, rb0, 0)
  GLOAD(ra1, rb1, 64)
  SSTORE(ra0, rb0, 0)
  __syncthreads();
  for (int kt = 0; kt < nk; kt += 2) {
    const int t2 = (kt + 2 < nk) ? kt + 2 : nk - 2;
    GLOAD(ra0, rb0, t2 << 6)
    __builtin_amdgcn_sched_barrier(0);
    COMPUTE(0)
    SSTORE(ra1, rb1, 1)
    __syncthreads();
    GLOAD(ra1, rb1, (t2 + 1) << 6)
    __builtin_amdgcn_sched_barrier(0);
    COMPUTE(1)
    SSTORE(ra0, rb0, 0)
    __syncthreads();
  }
#undef GLOAD
#undef SSTORE
#undef COMPUTE
}

template <int MB, int NB>
DI void zero_acc(f32x16 (&acc)[MB][NB]) {
#pragma unroll
  for (int mb = 0; mb < MB; ++mb)
#pragma unroll
    for (int nb = 0; nb < NB; ++nb)
#pragma unroll
      for (int i = 0; i < 16; ++i) acc[mb][nb][i] = 0.f;
}

#define EPI_LOOP(MB, NB, acc, BODY)                                              \
  {                                                                              \
    const int lane_ = tidx() & 63, wave_ = tidx() >> 6;                \
    const int wm_ = wave_ >> 1, wn_ = wave_ & 1, g_ = lane_ >> 5;                \
    _Pragma("unroll") for (int mb = 0; mb < MB; ++mb)                            \
    _Pragma("unroll") for (int nb = 0; nb < NB; ++nb)                            \
    _Pragma("unroll") for (int q4 = 0; q4 < 4; ++q4) {                           \
      const int er = wm_ * 32 * MB + mb * 32 + 8 * q4 + 4 * g_;                  \
      const int ec = wn_ * 32 * NB + nb * 32 + (lane_ & 31);                     \
      const float v0 = acc[mb][nb][4 * q4 + 0], v1 = acc[mb][nb][4 * q4 + 1];    \
      const float v2 = acc[mb][nb][4 * q4 + 2], v3 = acc[mb][nb][4 * q4 + 3];    \
      BODY                                                                       \
    }                                                                            \
  }


template <int MB, int NB>
DI void gemm512_core(const u16* __restrict__ A, int lda, const u16* __restrict__ B, int ldb, int nvalid, int K,
                     f32x16 (&acc)[MB][NB], char* smem) {
  constexpr int BM = 128 * MB, BN = 64 * NB;
  constexpr int LROW = 144;
  constexpr int ACH = BM / 64, BCH = BN / 64;
  char* As = smem;
  char* Bs = smem + 2 * BM * LROW;
  const int tid = tidx512(), lane = tid & 63, wave = tid >> 6, wm = wave >> 1, wn = wave & 1;
  u32x4 ra[ACH], rb[BCH];
  const int crow_ = tid >> 3, ckc = tid & 7;
  const unsigned aoff = (unsigned)(crow_ * lda + ckc * 8) * 2u;
  unsigned boff[BCH];
#pragma unroll
  for (int i = 0; i < BCH; ++i) {
    int r = crow_ + 64 * i;
    r = r < nvalid ? r : nvalid - 1;
    boff[i] = (unsigned)(r * ldb + ckc * 8) * 2u;
  }
  const char* const Ab = (const char*)A;
  const char* const Bb = (const char*)B;
  const size_t astep = (size_t)64 * lda * 2;
  int nk = K >> 6;
  asm volatile("" : "+s"(nk));
  char* const as_w = As + crow_ * LROW + ckc * 16;
  char* const bs_w = Bs + crow_ * LROW + ckc * 16;
  const char* const a_rd = As + (wm * 32 * MB + (lane & 31)) * LROW + (lane >> 5) * 16;
  const char* const b_rd = Bs + (wn * 32 * NB + (lane & 31)) * LROW + (lane >> 5) * 16;
#define GLOAD5(K0)                                                                      \
  {                                                                                     \
    _Pragma("unroll") for (int i = 0; i < ACH; ++i) ra[i] = *(const u32x4*)(Ab + (size_t)i * astep + (size_t)(K0) * 2 + aoff); \
    _Pragma("unroll") for (int i = 0; i < BCH; ++i) rb[i] = *(const u32x4*)(Bb + (size_t)(K0) * 2 + boff[i]); \
  }
#define SSTORE5(BUF)                                                                                     \
  {                                                                                                      \
    _Pragma("unroll") for (int i = 0; i < ACH; ++i) *(u32x4*)(as_w + ((BUF) * BM + 64 * i) * LROW) = ra[i]; \
    _Pragma("unroll") for (int i = 0; i < BCH; ++i) *(u32x4*)(bs_w + ((BUF) * BN + 64 * i) * LROW) = rb[i]; \
  }
  GLOAD5(0)
  SSTORE5(0)
  GLOAD5(64)
  __syncthreads();
  for (int kt = 0; kt < nk; ++kt) {
    const int buf = kt & 1;
    const int t2 = (kt + 2 < nk) ? kt + 2 : nk - 1;
    const size_t k2 = (size_t)(t2 << 6) * 2;
#pragma unroll
    for (int s = 0; s < 4; ++s) {
      bf16x8 af[MB], bfr[NB];
#pragma unroll
      for (int mb = 0; mb < MB; ++mb) af[mb] = *(const bf16x8*)(a_rd + (buf * BM + mb * 32) * LROW + s * 32);
#pragma unroll
      for (int nb = 0; nb < NB; ++nb) bfr[nb] = *(const bf16x8*)(b_rd + (buf * BN + nb * 32) * LROW + s * 32);
      if (s < ACH) {
        *(u32x4*)(as_w + ((buf ^ 1) * BM + 64 * s) * LROW) = ra[s];
        ra[s] = *(const u32x4*)(Ab + (size_t)s * astep + k2 + aoff);
      }
      if (s < BCH) {
        *(u32x4*)(bs_w + ((buf ^ 1) * BN + 64 * s) * LROW) = rb[s];
        rb[s] = *(const u32x4*)(Bb + k2 + boff[s]);
      }
      __builtin_amdgcn_sched_barrier(0);
#pragma unroll
      for (int mb = 0; mb < MB; ++mb)
#pragma unroll
        for (int nb = 0; nb < NB; ++nb) acc[mb][nb] = MFMA32(af[mb], bfr[nb], acc[mb][nb]);
    }
    __syncthreads();
  }
#undef GLOAD5
#undef SSTORE5
}


template <int NB>
struct GDesc512 { const char* Ab; const char* Bb; size_t astep; unsigned aoff; unsigned boff[NB]; int nk; };

template <int NB>
DI GDesc512<NB> make_gdesc(const u16* A, int lda, const u16* B, int ldb, int nvalid, int K) {
  const int tid = tidx512();
  const int crow_ = tid >> 3, ckc = tid & 7;
  GDesc512<NB> d;
  d.Ab = (const char*)A; d.Bb = (const char*)B;
  d.astep = (size_t)64 * lda * 2;
  d.aoff = (unsigned)(crow_ * lda + ckc * 8) * 2u;
#pragma unroll
  for (int i = 0; i < NB; ++i) {
    int r = crow_ + 64 * i;
    r = r < nvalid ? r : nvalid - 1;
    d.boff[i] = (unsigned)(r * ldb + ckc * 8) * 2u;
  }
  d.nk = K >> 6;
  return d;
}

template <int MB, int NB>
DI void gemm512_chain(const GDesc512<NB>& c, const GDesc512<NB>& n, bool has_next, bool preloaded,
                      u32x4 (&ra)[2 * MB], u32x4 (&rb)[NB], f32x16 (&acc)[MB][NB], char* smem) {
  constexpr int BM = 128 * MB, BN = 64 * NB;
  constexpr int LROW = 144;
  constexpr int ACH = 2 * MB, BCH = NB;
  char* As = smem;
  char* Bs = smem + 2 * BM * LROW;
  const int tid = tidx512(), lane = tid & 63, wave = tid >> 6, wm = wave >> 1, wn = wave & 1;
  const int crow_ = tid >> 3, ckc = tid & 7;
  int nk = c.nk;
  asm volatile("" : "+s"(nk));
  char* const as_w = As + crow_ * LROW + ckc * 16;
  char* const bs_w = Bs + crow_ * LROW + ckc * 16;
  const char* const a_rd = As + (wm * 32 * MB + (lane & 31)) * LROW + (lane >> 5) * 16;
  const char* const b_rd = Bs + (wn * 32 * NB + (lane & 31)) * LROW + (lane >> 5) * 16;
  if (!preloaded) {
#pragma unroll
    for (int i = 0; i < ACH; ++i) ra[i] = *(const u32x4*)(c.Ab + (size_t)i * c.astep + c.aoff);
#pragma unroll
    for (int i = 0; i < BCH; ++i) rb[i] = *(const u32x4*)(c.Bb + c.boff[i]);
#pragma unroll
    for (int i = 0; i < ACH; ++i) *(u32x4*)(as_w + (64 * i) * LROW) = ra[i];
#pragma unroll
    for (int i = 0; i < BCH; ++i) *(u32x4*)(bs_w + (64 * i) * LROW) = rb[i];
#pragma unroll
    for (int i = 0; i < ACH; ++i) ra[i] = *(const u32x4*)(c.Ab + (size_t)i * c.astep + 128 + c.aoff);
#pragma unroll
    for (int i = 0; i < BCH; ++i) rb[i] = *(const u32x4*)(c.Bb + 128 + c.boff[i]);
    __syncthreads();
  }
#define CH_ITER(BUF, SAB, SASTEP, SAOFF, SBB, SBOFF, K2)                                                   \
  {                                                                                                        \
    _Pragma("unroll") for (int s = 0; s < 4; ++s) {                                                        \
      bf16x8 af[MB], bfr[NB];                                                                              \
      _Pragma("unroll") for (int mb = 0; mb < MB; ++mb)                                                    \
        af[mb] = *(const bf16x8*)(a_rd + ((BUF) * BM + mb * 32) * LROW + s * 32);                          \
      _Pragma("unroll") for (int nb = 0; nb < NB; ++nb)                                                    \
        bfr[nb] = *(const bf16x8*)(b_rd + ((BUF) * BN + nb * 32) * LROW + s * 32);                         \
      if (s < ACH) {                                                                                       \
        *(u32x4*)(as_w + (((BUF) ^ 1) * BM + 64 * s) * LROW) = ra[s];                                      \
        ra[s] = *(const u32x4*)((SAB) + (size_t)s * (SASTEP) + (K2) + (SAOFF));                            \
      }                                                                                                    \
      if (s < BCH) {                                                                                       \
        *(u32x4*)(bs_w + (((BUF) ^ 1) * BN + 64 * s) * LROW) = rb[s];                                      \
        rb[s] = *(const u32x4*)((SBB) + (K2) + (SBOFF)[s]);                                                \
      }                                                                                                    \
      __builtin_amdgcn_sched_barrier(0);                                                                   \
      _Pragma("unroll") for (int mb = 0; mb < MB; ++mb)                                                    \
        _Pragma("unroll") for (int nb = 0; nb < NB; ++nb) acc[mb][nb] = MFMA32(af[mb], bfr[nb], acc[mb][nb]); \
    }                                                                                                      \
    __syncthreads();                                                                                       \
  }
  for (int kt = 0; kt < nk - 2; ++kt) {
    const int buf = kt & 1;
    const size_t k2 = (size_t)(kt + 2) * 128;
    CH_ITER(buf, c.Ab, c.astep, c.aoff, c.Bb, c.boff, k2)
  }
  {
    const char* tAb = has_next ? n.Ab : c.Ab;
    const char* tBb = has_next ? n.Bb : c.Bb;
    const size_t tastep = has_next ? n.astep : c.astep;
    const unsigned taoff = has_next ? n.aoff : c.aoff;
    unsigned tboff[NB];
#pragma unroll
    for (int i = 0; i < NB; ++i) tboff[i] = has_next ? n.boff[i] : c.boff[i];
    const size_t k2a = has_next ? (size_t)0 : (size_t)(nk - 1) * 128;
    const size_t k2b = has_next ? (size_t)128 : (size_t)(nk - 1) * 128;
    CH_ITER(0, tAb, tastep, taoff, tBb, tboff, k2a)
    CH_ITER(1, tAb, tastep, taoff, tBb, tboff, k2b)
  }
#undef CH_ITER
}

#define EPI512(MB, NB, acc, BODY)                                                \
  {                                                                              \
    const int t5_ = tidx512();                                                   \
    const int lane_ = t5_ & 63, wave_ = t5_ >> 6;                                \
    const int wm_ = wave_ >> 1, wn_ = wave_ & 1, g_ = lane_ >> 5;                \
    _Pragma("unroll") for (int mb = 0; mb < MB; ++mb)                            \
    _Pragma("unroll") for (int nb = 0; nb < NB; ++nb)                            \
    _Pragma("unroll") for (int q4 = 0; q4 < 4; ++q4) {                           \
      const int er = wm_ * 32 * MB + mb * 32 + 8 * q4 + 4 * g_;                  \
      const int ec = wn_ * 32 * NB + nb * 32 + (lane_ & 31);                     \
      const float v0 = acc[mb][nb][4 * q4 + 0], v1 = acc[mb][nb][4 * q4 + 1];    \
      const float v2 = acc[mb][nb][4 * q4 + 2], v3 = acc[mb][nb][4 * q4 + 3];    \
      BODY                                                                       \
    }                                                                            \
  }

DI int ffn_perm(int n) {
  int j = n < FFH ? n : n - FFH;
  return (j >> 5) * 64 + (j & 31) + (n < FFH ? 0 : 32);
}
DI void wtrans_tile(const float* __restrict__ src, int K, int N, int kt, int nt4, u16* __restrict__ dst, bool perm, char* smem) {
  float(*s)[65] = (float(*)[65])smem;
  const int tid = tidx();
  const int k0 = kt * 64;
  float4 v[4][4];
#pragma unroll
  for (int q = 0; q < 4; ++q)
#pragma unroll
    for (int i = 0; i < 4; ++i) {
      int r = (tid >> 4) + 16 * i, c4 = tid & 15;
      int n = (nt4 * 4 + q) * 64 + c4 * 4;
      v[q][i] = make_float4(0.f, 0.f, 0.f, 0.f);
      if (n < N) v[q][i] = ldnt4(src + (size_t)(k0 + r) * N + n);
    }
#pragma unroll
  for (int q = 0; q < 4; ++q) {
    const int n0 = (nt4 * 4 + q) * 64;
#pragma unroll
    for (int i = 0; i < 4; ++i) {
      int r = (tid >> 4) + 16 * i, c4 = tid & 15;
      s[r][c4 * 4 + 0] = v[q][i].x; s[r][c4 * 4 + 1] = v[q][i].y; s[r][c4 * 4 + 2] = v[q][i].z; s[r][c4 * 4 + 3] = v[q][i].w;
    }
    __syncthreads();
#pragma unroll
    for (int j = 0; j < 2; ++j) {
      int ch = tid + 256 * j;
      int n = ch >> 3, kc = ch & 7;
      if (n0 + n < N) {
        int dn = perm ? ffn_perm(n0 + n) : (n0 + n);
        uint4 o;
        o.x = pk2(s[kc * 8 + 0][n], s[kc * 8 + 1][n]);
        o.y = pk2(s[kc * 8 + 2][n], s[kc * 8 + 3][n]);
        o.z = pk2(s[kc * 8 + 4][n], s[kc * 8 + 5][n]);
        o.w = pk2(s[kc * 8 + 6][n], s[kc * 8 + 7][n]);
        *(uint4*)(dst + (size_t)dn * K + k0 + kc * 8) = o;
      }
    }
    __syncthreads();
  }
}

template <bool F32SRC>
DI void tr32x128(const void* src, size_t sstride, u16* dst, size_t dstride, char* smem) {
  u16(*s)[136] = (u16(*)[136])smem;
  const int tid = tidx();
  const int r = tid >> 3, c16 = (tid & 7) * 16;
  if (F32SRC) {
    const float* sp = (const float*)src + (size_t)r * sstride + c16;
#pragma unroll
    for (int i = 0; i < 4; ++i) {
      float4 v = ldnt4(sp + 4 * i);
      *(uint2*)(&s[r][c16 + 4 * i]) = pk4(v.x, v.y, v.z, v.w);
    }
  } else {
    const u16* sp = (const u16*)src + (size_t)r * sstride + c16;
    uint4 a = *(const uint4*)(sp), b = *(const uint4*)(sp + 8);
    *(uint4*)(&s[r][c16]) = a;
    *(uint4*)(&s[r][c16 + 8]) = b;
  }
  __syncthreads();
#pragma unroll
  for (int j = 0; j < 2; ++j) {
    int ch = tid + 256 * j;
    int col = ch >> 2, kc = ch & 3;
    uint4 o;
    o.x = (unsigned)s[kc * 8 + 0][col] | ((unsigned)s[kc * 8 + 1][col] << 16);
    o.y = (unsigned)s[kc * 8 + 2][col] | ((unsigned)s[kc * 8 + 3][col] << 16);
    o.z = (unsigned)s[kc * 8 + 4][col] | ((unsigned)s[kc * 8 + 5][col] << 16);
    o.w = (unsigned)s[kc * 8 + 6][col] | ((unsigned)s[kc * 8 + 7][col] << 16);
    *(uint4*)(dst + (size_t)col * dstride + kc * 8) = o;
  }
  __syncthreads();
}

DI void adaln_job(const Params& p_in, int l, int jg, char* smem) {
  Params p = p_in; launder_params(p);
  float* sc = (float*)smem;
  float* red = sc + 5 * 1024;
  const int tid = tidx(), lane = tid & 63, wave = tid >> 6;
  for (int idx = tid; idx < 5 * 1024; idx += 256) {
    int c = idx >> 10, k = idx & 1023;
    float v = (c == 0) ? p.c_ctx[k] : p.c[(c - 1) * 1024 + k];
    sc[idx] = siluf_(v);
  }
  __syncthreads();
  const int j = jg * 64 + lane;
  float acc[5] = {0.f, 0.f, 0.f, 0.f, 0.f};
  const float* wp = p.w_ada + ((size_t)l * 1024 + wave * 256) * 6144 + j;
  const float* sp = sc + wave * 256;
#pragma unroll 32
  for (int k = 0; k < 256; ++k) {
    float wv = __builtin_nontemporal_load(wp + (size_t)k * 6144);
#pragma unroll
    for (int c = 0; c < 5; ++c) acc[c] += sp[c * 1024 + k] * wv;
  }
#pragma unroll
  for (int c = 0; c < 5; ++c) red[(wave * 5 + c) * 64 + lane] = acc[c];
  __syncthreads();
  for (int t2 = tid; t2 < 320; t2 += 256) {
    int c = t2 >> 6, ln = t2 & 63;
    float v = red[(0 * 5 + c) * 64 + ln] + red[(1 * 5 + c) * 64 + ln] + red[(2 * 5 + c) * 64 + ln] + red[(3 * 5 + c) * 64 + ln];
    v += p.b_ada[l * 6144 + jg * 64 + ln];
    ((float*)(p.ws + W_MOD))[(size_t)(l * 5 + c) * 6144 + jg * 64 + ln] = v;
  }
  __syncthreads();
}

DI void misc_job(const Params& p_in, int j) {
  Params p = p_in; launder_params(p);
  const int tid = tidx();
  if (j < 16) {
    float2* rb = (float2*)(p.ws + W_ROPEB);
    float2* rd = (float2*)(p.ws + W_ROPED);
    for (int idx = tid; idx < 64 * 32; idx += 256) {
      int t = j * 64 + (idx >> 5), pp = idx & 31;
      int fi = pp & 15;
      float inv = exp2f(-(float)fi * (13.287712379549449f / 16.f));
      float pos = (pp < 16) ? (float)(t >> 6) : (float)(t & 63);
      float a = pos * inv;
      rb[t * 32 + pp] = make_float2(cosf(a), sinf(a));
    }
    for (int idx = tid; idx < 64 * 16; idx += 256) {
      int t = j * 64 + (idx >> 4), pp = idx & 15;
      int fi = pp & 7;
      float inv = exp2f(-(float)fi * (13.287712379549449f / 8.f));
      float pos = (pp < 8) ? (float)(t >> 6) : (float)(t & 63);
      float a = pos * inv;
      rd[t * 16 + pp] = make_float2(cosf(a), sinf(a));
    }
  } else if (j == 16) {
    float* lbv = (float*)(p.ws + W_LBV);
    for (int idx = tid; idx < 1024; idx += 256) {
      float a0 = p.lb_logits[idx], a1 = p.lb_logits[1024 + idx];
      lbv[idx] = 0.f;
      lbv[1024 + idx] = sigmoidf_(a1 - a0);
    }
  }
}

DI void cache_job(const Params& p_in, int l, int j, char* smem) {
  Params p = p_in; launder_params(p);
  const int b = j >> 4, p0 = (j & 15) * 32;
  const int tid = tidx();
  const size_t cb = (size_t)(b * 2 + l) * 512 + p0;
  {
    const float* src = p.cgk + cb * 128;
    u16* dst = (u16*)(p.ws + W_KBL) + ((size_t)b * 1536 + p0) * 128;
    for (int idx = tid; idx < 32 * 32; idx += 256) {
      float4 v = ldnt4(src + idx * 4);
      *(uint2*)(dst + idx * 4) = pk4(v.x, v.y, v.z, v.w);
    }
  }
  tr32x128<true>(p.cgv + cb * 128, 128, (u16*)(p.ws + W_VBTL) + (size_t)b * 128 * 1536 + p0, 1536, smem);
  {
    const float* src = p.cnk + cb * 512;
    u16* dst = (u16*)(p.ws + W_NKC) + ((size_t)b * 512 + p0) * 512;
    for (int idx = tid; idx < 32 * 128; idx += 256) {
      float4 v = ldnt4(src + idx * 4);
      *(uint2*)(dst + idx * 4) = pk4(v.x, v.y, v.z, v.w);
    }
  }
  for (int cc = 0; cc < 4; ++cc)
    tr32x128<true>(p.cnv + cb * 512 + cc * 128, 512, (u16*)(p.ws + W_NVTL) + ((size_t)b * 512 + cc * 128) * 1536 + p0, 1536, smem);
  {
    const float* src = p.cckv + cb * 128;
    u16* dst = (u16*)(p.ws + W_ACKV) + ((size_t)8192 + b * 512 + p0) * 128;
    for (int idx = tid; idx < 32 * 32; idx += 256) {
      float4 v = ldnt4(src + idx * 4);
      *(uint2*)(dst + idx * 4) = pk4(v.x, v.y, v.z, v.w);
    }
  }
  {
    const int r = tid >> 3, li = tid & 7;
    float4 v = ldnt4(p.ckr + (cb + r) * 32 + li * 4);
    uint2 o = pk4(v.x, v.y, v.z, v.w);
    u16* dst = (u16*)(p.ws + W_KDL) + ((size_t)b * 1536 + p0 + r) * 768 + 64 + li * 4;
#pragma unroll
    for (int h = 0; h < 8; ++h) *(uint2*)(dst + h * 96) = o;
  }
}

DI void norm_job(const Params& p_in, int l, int which, int job, bool from_input) {
  Params p = p_in; launder_params(p);
  const int tid = tidx(), lane = tid & 63, wave = tid >> 6;
  const int row = job * 4 + wave;
  const float* xs;
  if (from_input) xs = row < NCTX ? p.x_prompt + (size_t)row * D : p.x_sample + (size_t)(row - NCTX) * D;
  else xs = p.out + (size_t)row * D;
  float4 v[4];
  float ss = 0.f;
#pragma unroll
  for (int i = 0; i < 4; ++i) {
    v[i] = from_input ? ldnt4(xs + (i * 64 + lane) * 4) : *(const float4*)(xs + (i * 64 + lane) * 4);
    ss += v[i].x * v[i].x + v[i].y * v[i].y + v[i].z * v[i].z + v[i].w * v[i].w;
  }
#pragma unroll
  for (int o = 32; o >= 1; o >>= 1) ss += shx(ss, o);
  const float rstd = rsqrtf(ss * (1.f / 1024.f) + EPS);
  const int cond = cond_of_row(row);
  const float* mod = (const float*)(p.ws + W_MOD) + (size_t)(l * 5 + cond) * 6144;
  const float* sh = mod + (which ? 3 : 0) * 1024;
  const float* sc = mod + (which ? 4 : 1) * 1024;
  u16* hb = (u16*)(p.ws + W_H) + (size_t)row * D;
#pragma unroll
  for (int i = 0; i < 4; ++i) {
    int c = (i * 64 + lane) * 4;
    float4 a = *(const float4*)(sc + c), s = *(const float4*)(sh + c);
    *(uint2*)(hb + c) = pk4(v[i].x * rstd * (1.f + a.x) + s.x, v[i].y * rstd * (1.f + a.y) + s.y,
                            v[i].z * rstd * (1.f + a.z) + s.z, v[i].w * rstd * (1.f + a.w) + s.w);
    if (from_input) *(float4*)(p.out + (size_t)row * D + c) = v[i];
  }
}

DI void final_norm_job(const Params& p_in, int job) {
  Params p = p_in; launder_params(p);
  const int tid = tidx(), lane = tid & 63, wave = tid >> 6;
  const int row = job * 4 + wave;
  float* xs = p.out + (size_t)row * D;
  float4 v[4];
  float ss = 0.f;
#pragma unroll
  for (int i = 0; i < 4; ++i) {
    v[i] = *(const float4*)(xs + (i * 64 + lane) * 4);
    ss += v[i].x * v[i].x + v[i].y * v[i].y + v[i].z * v[i].z + v[i].w * v[i].w;
  }
#pragma unroll
  for (int o = 32; o >= 1; o >>= 1) ss += shx(ss, o);
  const float rstd = rsqrtf(ss * (1.f / 1024.f) + EPS);
#pragma unroll
  for (int i = 0; i < 4; ++i) {
    int c = (i * 64 + lane) * 4;
    float4 g = *(const float4*)(p.final_gain + c);
    stnt4(xs + c, make_float4(v[i].x * rstd * g.x, v[i].y * rstd * g.y, v[i].z * rstd * g.z, v[i].w * rstd * g.w));
  }
}

DI void prep_job(const Params& p_in, int l, int tile, int part, char* smem) {
  Params p = p_in; launder_params(p);
  const int row0 = tile * 32;
  const bool ctx = row0 < NCTX;
  int b, t0;
  if (ctx) { b = row0 >> 8; t0 = row0 & 255; } else { int rr = row0 - NCTX; b = rr >> 10; t0 = rr & 1023; }
  const u16* pr = (const u16*)(p.ws + W_PROJ) + (size_t)row0 * PW;
  const int tid = tidx(), lane = tid & 63, wave = tid >> 6;
  const float2* ropeB = (const float2*)(p.ws + W_ROPEB);
  const float2* ropeD = (const float2*)(p.ws + W_ROPED);
  const size_t cbase = (size_t)(b * 2 + l) * 256 + t0;

  if (part == 0) {
    const int li = tid & 15;
    const float4 gn = *(const float4*)(p.gq_q_gain + l * 64 + li * 4);
#pragma unroll 8
    for (int pass = 0; pass < 16; ++pass) {
      int vec = pass * 16 + (tid >> 4);
      int r = vec >> 3, h = vec & 7;
      float x[4];
      unpack4(*(const uint2*)(pr + (size_t)r * PW + C_GQ + h * 64 + li * 4), x);
      float ss = x[0] * x[0] + x[1] * x[1] + x[2] * x[2] + x[3] * x[3];
      ss += shx(ss, 1); ss += shx(ss, 2); ss += shx(ss, 4); ss += shx(ss, 8);
      float rstd = rsqrtf(ss * (1.f / 64.f) + EPS);
      float y0 = x[0] * rstd * gn.x, y1 = x[1] * rstd * gn.y, y2 = x[2] * rstd * gn.z, y3 = x[3] * rstd * gn.w;
      if (!ctx) {
        float2 c0 = ropeB[(t0 + r) * 32 + 2 * li], c1 = ropeB[(t0 + r) * 32 + 2 * li + 1];
        float a0 = y0 * c0.x - y1 * c0.y, a1 = y0 * c0.y + y1 * c0.x;
        float a2 = y2 * c1.x - y3 * c1.y, a3 = y2 * c1.y + y3 * c1.x;
        y0 = a0; y1 = a1; y2 = a2; y3 = a3;
      }
      *(uint2*)((u16*)(p.ws + W_QBF) + (size_t)(row0 + r) * 512 + h * 64 + li * 4) = pk4(y0, y1, y2, y3);
    }
  }
  if (part == 0) {
    const int li = tid & 15;
    const float4 gn = *(const float4*)(p.gq_k_gain + l * 64 + li * 4);
#pragma unroll
    for (int pass = 0; pass < 4; ++pass) {
      int vec = pass * 16 + (tid >> 4);
      int r = vec >> 1, kvh = vec & 1;
      float x[4];
      unpack4(*(const uint2*)(pr + (size_t)r * PW + C_GK + kvh * 64 + li * 4), x);
      float ss = x[0] * x[0] + x[1] * x[1] + x[2] * x[2] + x[3] * x[3];
      ss += shx(ss, 1); ss += shx(ss, 2); ss += shx(ss, 4); ss += shx(ss, 8);
      float rstd = rsqrtf(ss * (1.f / 64.f) + EPS);
      float y0 = x[0] * rstd * gn.x, y1 = x[1] * rstd * gn.y, y2 = x[2] * rstd * gn.z, y3 = x[3] * rstd * gn.w;
      if (ctx) {
        stnt4(p.out + O_GQK + (cbase + r) * 128 + kvh * 64 + li * 4, make_float4(y0, y1, y2, y3));
        *(uint2*)((u16*)(p.ws + W_KBC) + (size_t)(row0 + r) * 128 + kvh * 64 + li * 4) = pk4(y0, y1, y2, y3);
      } else {
        float2 c0 = ropeB[(t0 + r) * 32 + 2 * li], c1 = ropeB[(t0 + r) * 32 + 2 * li + 1];
        float a0 = y0 * c0.x - y1 * c0.y, a1 = y0 * c0.y + y1 * c0.x;
        float a2 = y2 * c1.x - y3 * c1.y, a3 = y2 * c1.y + y3 * c1.x;
        *(uint2*)((u16*)(p.ws + W_KBL) + ((size_t)b * 1536 + 512 + t0 + r) * 128 + kvh * 64 + li * 4) = pk4(a0, a1, a2, a3);
      }
    }
  }
  if (part == 1) {
  if (ctx) {
    for (int idx = tid; idx < 32 * 32; idx += 256) {
      int r = idx >> 5, c4 = (idx & 31) * 4;
      float x[4];
      unpack4(*(const uint2*)(pr + (size_t)r * PW + C_GV + c4), x);
      stnt4(p.out + O_GQV + (cbase + r) * 128 + c4, make_float4(x[0], x[1], x[2], x[3]));
    }
    tr32x128<false>(pr + C_GV, PW, (u16*)(p.ws + W_VBTC) + (size_t)b * 128 * 256 + t0, 256, smem);
  } else {
    tr32x128<false>(pr + C_GV, PW, (u16*)(p.ws + W_VBTL) + (size_t)b * 128 * 1536 + 512 + t0, 1536, smem);
  }
  if (ctx) {
    for (int idx = tid; idx < 32 * 128; idx += 256) {
      int r = idx >> 7, c4 = (idx & 127) * 4;
      float x[4];
      unpack4(*(const uint2*)(pr + (size_t)r * PW + C_NK + c4), x);
      stnt4(p.out + O_NAK + (cbase + r) * 512 + c4, make_float4(x[0], x[1], x[2], x[3]));
      unpack4(*(const uint2*)(pr + (size_t)r * PW + C_NV + c4), x);
      stnt4(p.out + O_NAV + (cbase + r) * 512 + c4, make_float4(x[0], x[1], x[2], x[3]));
    }
    for (int cc = 0; cc < 4; ++cc)
      tr32x128<false>(pr + C_NV + cc * 128, PW, (u16*)(p.ws + W_NVTC) + ((size_t)b * 512 + cc * 128) * 256 + t0, 256, smem);
  } else {
    for (int cc = 0; cc < 4; ++cc)
      tr32x128<false>(pr + C_NV + cc * 128, PW, (u16*)(p.ws + W_NVTL) + ((size_t)b * 512 + cc * 128) * 1536 + 512 + t0, 1536, smem);
  }
  }
  if (part == 0) {
    const float4 gn = *(const float4*)(p.ml_q_a_gain + l * 256 + lane * 4);
#pragma unroll
    for (int pass = 0; pass < 8; ++pass) {
      int r = pass * 4 + wave;
      float x[4];
      unpack4(*(const uint2*)(pr + (size_t)r * PW + C_MQA + lane * 4), x);
      float ss = x[0] * x[0] + x[1] * x[1] + x[2] * x[2] + x[3] * x[3];
#pragma unroll
      for (int o = 32; o >= 1; o >>= 1) ss += shx(ss, o);
      float rstd = rsqrtf(ss * (1.f / 256.f) + EPS);
      *(uint2*)((u16*)(p.ws + W_AQ) + (size_t)(row0 + r) * 256 + lane * 4) =
          pk4(x[0] * rstd * gn.x, x[1] * rstd * gn.y, x[2] * rstd * gn.z, x[3] * rstd * gn.w);
    }
  }
  if (part == 0) {
    const int li = tid & 31;
    const float4 gn = *(const float4*)(p.ml_kv_a_gain + l * 128 + li * 4);
#pragma unroll
    for (int pass = 0; pass < 4; ++pass) {
      int r = pass * 8 + (tid >> 5);
      float x[4];
      unpack4(*(const uint2*)(pr + (size_t)r * PW + C_MKVA + li * 4), x);
      float ss = x[0] * x[0] + x[1] * x[1] + x[2] * x[2] + x[3] * x[3];
#pragma unroll
      for (int o = 16; o >= 1; o >>= 1) ss += shx(ss, o);
      float rstd = rsqrtf(ss * (1.f / 128.f) + EPS);
      float y0 = x[0] * rstd * gn.x, y1 = x[1] * rstd * gn.y, y2 = x[2] * rstd * gn.z, y3 = x[3] * rstd * gn.w;
      *(uint2*)((u16*)(p.ws + W_ACKV) + (size_t)(row0 + r) * 128 + li * 4) = pk4(y0, y1, y2, y3);
      if (ctx) stnt4(p.out + O_CKV + (cbase + r) * 128 + li * 4, make_float4(y0, y1, y2, y3));
    }
  }
  if (part == 0) {
    const int r = tid >> 3, li = tid & 7;
    float x[4];
    unpack4(*(const uint2*)(pr + (size_t)r * PW + C_MKR + li * 4), x);
    if (ctx) {
      stnt4(p.out + O_KR + (cbase + r) * 32 + li * 4, make_float4(x[0], x[1], x[2], x[3]));
      uint2 o = pk4(x[0], x[1], x[2], x[3]);
      u16* dst = (u16*)(p.ws + W_KDC) + (size_t)(row0 + r) * 768 + 64 + li * 4;
#pragma unroll
      for (int h = 0; h < 8; ++h) *(uint2*)(dst + h * 96) = o;
    } else {
      float2 c0 = ropeD[(t0 + r) * 16 + 2 * li], c1 = ropeD[(t0 + r) * 16 + 2 * li + 1];
      float a0 = x[0] * c0.x - x[1] * c0.y, a1 = x[0] * c0.y + x[1] * c0.x;
      float a2 = x[2] * c1.x - x[3] * c1.y, a3 = x[2] * c1.y + x[3] * c1.x;
      uint2 o = pk4(a0, a1, a2, a3);
      u16* dst = (u16*)(p.ws + W_KDL) + ((size_t)b * 1536 + 512 + t0 + r) * 768 + 64 + li * 4;
#pragma unroll
      for (int h = 0; h < 8; ++h) *(uint2*)(dst + h * 96) = o;
    }
  }
}

struct AttnP {
  const u16* q; size_t qs;
  const u16* k; size_t ks;
  const u16* vt; size_t vs;
  int ntiles;
  float sscale;
  u16* o; size_t os;
  const float2* rope; int tq;
  const u16* k2; size_t ks2;
  int grow, c0;
  int krlo;
  const float* rpbs;
};

template <int DK, int MODE>
DI void attn_block(const AttnP& a, char* smem) {
  constexpr int NS = DK / 16;
  constexpr int KROW = DK * 2 + 16;
  constexpr int VROW = 144;
  constexpr int KCH = DK / 8;
  constexpr int KPT = KCH * 64 / 256;
  char* Ks = smem;
  char* Vs = smem + 2 * 64 * KROW;
  const int tid = tidx(), lane = tid & 63, r = lane & 31, g = lane >> 5;
  bf16x8 qf[NS];
#pragma unroll
  for (int s = 0; s < NS; ++s) qf[s] = *(const bf16x8*)(a.q + (size_t)r * a.qs + 16 * s + 8 * g);
  if (MODE == 1) {
#pragma unroll
    for (int s = 4; s < 6; ++s) {
      uint4 u = __builtin_bit_cast(uint4, qf[s]);
      float x[8];
      unpack8(u, x);
      const float2* rp = a.rope + (size_t)(a.tq + r) * 16 + (s - 4) * 8 + 4 * g;
      float y[8];
#pragma unroll
      for (int pp = 0; pp < 4; ++pp) {
        float2 cs = rp[pp];
        y[2 * pp] = x[2 * pp] * cs.x - x[2 * pp + 1] * cs.y;
        y[2 * pp + 1] = x[2 * pp] * cs.y + x[2 * pp + 1] * cs.x;
      }
      uint4 o;
      o.x = pk2(y[0], y[1]); o.y = pk2(y[2], y[3]); o.z = pk2(y[4], y[5]); o.w = pk2(y[6], y[7]);
      qf[s] = __builtin_bit_cast(bf16x8, o);
    }
  }
  f32x16 oacc[2];
#pragma unroll
  for (int i = 0; i < 16; ++i) { oacc[0][i] = 0.f; oacc[1][i] = 0.f; }
  float m = -1e30f, lsum = 0.f;
  int kr0 = 0, qc = 0, cs0 = 0;
  if (MODE == 2) {
    kr0 = a.grow - 4; kr0 = kr0 < 0 ? 0 : (kr0 > 8 ? 8 : kr0);
    qc = a.c0 + r;
    cs0 = qc - 8; cs0 = cs0 < 0 ? 0 : (cs0 > 48 ? 48 : cs0);
  }
  u32x4 rk[KPT], rv[2];
  int krow_i[KPT], kkc[KPT];
#pragma unroll
  for (int i = 0; i < KPT; ++i) { int c = tid + 256 * i; krow_i[i] = c / KCH; kkc[i] = c % KCH; }
  const int vrow_i = tid >> 3, vkc = tid & 7;
#define ATT_GLOAD(KT)                                                                                   \
  {                                                                                                     \
    const u16* kb_;                                                                                     \
    size_t kst_;                                                                                        \
    int vkey_;                                                                                          \
    if (MODE == 2 && (KT) >= 8) {                                                                       \
      int tok_ = (a.krlo + (KT) - 8) * 64;                                                              \
      kb_ = a.k2 + (size_t)tok_ * a.ks2; kst_ = a.ks2; vkey_ = 512 + tok_;                              \
    } else {                                                                                            \
      kb_ = a.k + (size_t)((KT) * 64) * a.ks; kst_ = a.ks; vkey_ = (KT) * 64;                           \
    }                                                                                                   \
    _Pragma("unroll") for (int i = 0; i < KPT; ++i)                                                     \
      rk[i] = *(const u32x4*)(kb_ + (size_t)krow_i[i] * kst_ + kkc[i] * 8);                             \
    rv[0] = *(const u32x4*)(a.vt + (size_t)vrow_i * a.vs + vkey_ + vkc * 8);                            \
    rv[1] = *(const u32x4*)(a.vt + (size_t)(vrow_i + 32) * a.vs + vkey_ + vkc * 8);                     \
  }
#define ATT_SSTORE(BUF)                                                                                 \
  {                                                                                                     \
    _Pragma("unroll") for (int i = 0; i < KPT; ++i)                                                     \
      *(u32x4*)(Ks + ((BUF) * 64 + krow_i[i]) * KROW + kkc[i] * 16) = rk[i];                            \
    *(u32x4*)(Vs + ((BUF) * 64 + vrow_i) * VROW + vkc * 16) = rv[0];                                    \
    *(u32x4*)(Vs + ((BUF) * 64 + vrow_i + 32) * VROW + vkc * 16) = rv[1];                               \
  }
  ATT_GLOAD(0)
  ATT_SSTORE(0)
  __syncthreads();
  for (int kt = 0; kt < a.ntiles; ++kt) {
    const int buf = kt & 1;
    const int ktn = (kt + 1 < a.ntiles) ? kt + 1 : kt;
    ATT_GLOAD(ktn)
    __builtin_amdgcn_sched_barrier(0);
    float sv[2][16];
#pragma unroll
    for (int u = 0; u < 2; ++u) {
      f32x16 sacc;
#pragma unroll
      for (int i = 0; i < 16; ++i) sacc[i] = 0.f;
      const char* kp = Ks + (buf * 64 + u * 32 + r) * KROW + g * 16;
#pragma unroll
      for (int s = 0; s < NS; ++s) sacc = MFMA32(*(const bf16x8*)(kp + s * 32), qf[s], sacc);
#pragma unroll
      for (int i = 0; i < 16; ++i) sv[u][i] = sacc[i];
    }
    float mn;
    if (MODE == 2 && kt >= 8) {
      const int krow_ = a.krlo + kt - 8;
      const bool rowok = (krow_ >= kr0) && (krow_ < kr0 + 8);
      int dr = krow_ - a.grow + 7;
      dr = dr < 0 ? 0 : (dr > 14 ? 14 : dr);
#pragma unroll
      for (int u = 0; u < 2; ++u)
#pragma unroll
        for (int i = 0; i < 16; ++i) {
          int kc = u * 32 + crow(i, g);
          bool ok = rowok && (kc >= cs0) && (kc < cs0 + 16);
          int dc = kc - qc + 15; dc = dc < 0 ? 0 : (dc > 30 ? 30 : dc);
          sv[u][i] = ok ? fmaf(sv[u][i], a.sscale, a.rpbs[dr * 31 + dc]) : -INFINITY;
        }
      float mx = sv[0][0];
#pragma unroll
      for (int u = 0; u < 2; ++u)
#pragma unroll
        for (int i = 0; i < 16; ++i) mx = fmaxf(mx, sv[u][i]);
      mx = fmaxf(mx, shx(mx, 32));
      mn = fmaxf(m, mx);
#pragma unroll
      for (int u = 0; u < 2; ++u)
#pragma unroll
        for (int i = 0; i < 16; ++i) sv[u][i] = __builtin_amdgcn_exp2f(sv[u][i] - mn);
    } else {
      float mx = sv[0][0];
#pragma unroll
      for (int u = 0; u < 2; ++u)
#pragma unroll
        for (int i = 0; i < 16; ++i) mx = fmaxf(mx, sv[u][i]);
      mx = fmaxf(mx, shx(mx, 32)) * a.sscale;
      mn = fmaxf(m, mx);
#pragma unroll
      for (int u = 0; u < 2; ++u)
#pragma unroll
        for (int i = 0; i < 16; ++i) sv[u][i] = __builtin_amdgcn_exp2f(fmaf(sv[u][i], a.sscale, -mn));
    }
    float ps = 0.f;
#pragma unroll
    for (int u = 0; u < 2; ++u)
#pragma unroll
      for (int i = 0; i < 16; ++i) ps += sv[u][i];
    if (__any(mn > m)) {
      const float alpha = __builtin_amdgcn_exp2f(m - mn);
      lsum *= alpha;
#pragma unroll
      for (int i = 0; i < 16; ++i) { oacc[0][i] *= alpha; oacc[1][i] *= alpha; }
      m = mn;
    }
    lsum += ps;
    ATT_SSTORE(buf ^ 1)
#pragma unroll
    for (int u = 0; u < 2; ++u)
#pragma unroll
      for (int s2 = 0; s2 < 2; ++s2) {
        uint4 pu;
        pu.x = pk2(sv[u][8 * s2 + 0], sv[u][8 * s2 + 1]); pu.y = pk2(sv[u][8 * s2 + 2], sv[u][8 * s2 + 3]);
        pu.z = pk2(sv[u][8 * s2 + 4], sv[u][8 * s2 + 5]); pu.w = pk2(sv[u][8 * s2 + 6], sv[u][8 * s2 + 7]);
        const bf16x8 pf = __builtin_bit_cast(bf16x8, pu);
#pragma unroll
        for (int mb = 0; mb < 2; ++mb) {
          const char* vp = Vs + (buf * 64 + mb * 32 + r) * VROW + (u * 32 + 16 * s2 + 4 * g) * 2;
          bf16x4 lo = *(const bf16x4*)(vp);
          bf16x4 hi = *(const bf16x4*)(vp + 16);
          oacc[mb] = MFMA32(__builtin_shufflevector(lo, hi, 0, 1, 2, 3, 4, 5, 6, 7), pf, oacc[mb]);
        }
      }
    __syncthreads();
  }
#undef ATT_GLOAD
#undef ATT_SSTORE
  lsum += shx(lsum, 32);
  const float inv = frcp(lsum);
#pragma unroll
  for (int mb = 0; mb < 2; ++mb)
#pragma unroll
    for (int q4 = 0; q4 < 4; ++q4) {
      int dv = mb * 32 + 8 * q4 + 4 * g;
      *(uint2*)(a.o + (size_t)r * a.os + dv) = pk4(oacc[mb][4 * q4 + 0] * inv, oacc[mb][4 * q4 + 1] * inv,
                                                    oacc[mb][4 * q4 + 2] * inv, oacc[mb][4 * q4 + 3] * inv);
    }
}

DI void gqa_item(const Params& p_in, int lat, int item, char* smem) {
  Params p = p_in; launder_params(p);
  const int wave = tidx() >> 6;
  AttnP a;
  a.sscale = 0.125f * LOG2E;
  a.rope = nullptr; a.tq = 0; a.k2 = nullptr; a.ks2 = 0; a.grow = 0; a.c0 = 0; a.rpbs = nullptr; a.krlo = 0;
  if (lat) {
    int b = item >> 6, h = (item >> 3) & 7, qt = item & 7;
    int row = NCTX + b * 1024 + qt * 128 + wave * 32;
    a.q = (const u16*)(p.ws + W_QBF) + (size_t)row * 512 + h * 64; a.qs = 512;
    a.k = (const u16*)(p.ws + W_KBL) + (size_t)b * 1536 * 128 + (h >> 2) * 64; a.ks = 128;
    a.vt = (const u16*)(p.ws + W_VBTL) + ((size_t)b * 128 + (h >> 2) * 64) * 1536; a.vs = 1536;
    a.ntiles = 24;
    a.o = (u16*)(p.ws + W_BRANCH) + (size_t)row * 2048 + 512 + h * 64; a.os = 2048;
  } else {
    int b = item >> 4, h = (item >> 1) & 7, qt = item & 1;
    int row = b * 256 + qt * 128 + wave * 32;
    a.q = (const u16*)(p.ws + W_QBF) + (size_t)row * 512 + h * 64; a.qs = 512;
    a.k = (const u16*)(p.ws + W_KBC) + (size_t)b * 256 * 128 + (h >> 2) * 64; a.ks = 128;
    a.vt = (const u16*)(p.ws + W_VBTC) + ((size_t)b * 128 + (h >> 2) * 64) * 256; a.vs = 256;
    a.ntiles = 4;
    a.o = (u16*)(p.ws + W_BRANCH) + (size_t)row * 2048 + 512 + h * 64; a.os = 2048;
  }
  attn_block<64, 0>(a, smem);
}

DI void na_ctx_item(const Params& p_in, int item, char* smem) {
  Params p = p_in; launder_params(p);
  const int wave = tidx() >> 6;
  AttnP a;
  a.sscale = 0.125f * LOG2E;
  a.rope = nullptr; a.tq = 0; a.k2 = nullptr; a.ks2 = 0; a.grow = 0; a.c0 = 0; a.rpbs = nullptr; a.krlo = 0;
  int b = item >> 4, h = (item >> 1) & 7, qt = item & 1;
  int row = b * 256 + qt * 128 + wave * 32;
  const u16* pr = (const u16*)(p.ws + W_PROJ);
  a.q = pr + (size_t)row * PW + C_NQ + h * 64; a.qs = PW;
  a.k = pr + (size_t)(b * 256) * PW + C_NK + h * 64; a.ks = PW;
  a.vt = (const u16*)(p.ws + W_NVTC) + ((size_t)b * 512 + h * 64) * 256; a.vs = 256;
  a.ntiles = 4;
  a.o = (u16*)(p.ws + W_BRANCH) + (size_t)row * 2048 + 1024 + h * 64; a.os = 2048;
  attn_block<64, 0>(a, smem);
}

DI void na_lat_item(const Params& p_in, int l, int item, char* smem) {
  Params p = p_in; launder_params(p);
  const int tid = tidx(), wave = tid >> 6;
  int b = item >> 6, h = (item >> 3) & 7, rp = item & 7;
  float* rpbs = (float*)(smem + 65536);
  for (int idx = tid; idx < 15 * 31; idx += 256) rpbs[idx] = p.na_rpb[(size_t)(l * 8 + h) * 465 + idx] * LOG2E;
  __syncthreads();
  AttnP a;
  a.sscale = 0.125f * LOG2E;
  a.rope = nullptr; a.tq = 0;
  const int grow = rp * 2 + (wave >> 1), c0 = (wave & 1) * 32;
  int row = NCTX + b * 1024 + grow * 64 + c0;
  const u16* pr = (const u16*)(p.ws + W_PROJ);
  a.q = pr + (size_t)row * PW + C_NQ + h * 64; a.qs = PW;
  a.k = (const u16*)(p.ws + W_NKC) + (size_t)b * 512 * 512 + h * 64; a.ks = 512;
  a.vt = (const u16*)(p.ws + W_NVTL) + ((size_t)b * 512 + h * 64) * 1536; a.vs = 1536;
  a.k2 = pr + (size_t)(NCTX + b * 1024) * PW + C_NK + h * 64; a.ks2 = PW;
  a.grow = grow; a.c0 = c0; a.rpbs = rpbs;
  int lo = rp * 2 - 4; lo = lo < 0 ? 0 : (lo > 8 ? 8 : lo);
  int hi = rp * 2 + 1 - 4; hi = hi < 0 ? 0 : (hi > 8 ? 8 : hi);
  a.krlo = lo;
  a.ntiles = 8 + (hi + 8 - lo);
  a.o = (u16*)(p.ws + W_BRANCH) + (size_t)row * 2048 + 1024 + h * 64; a.os = 2048;
  attn_block<64, 2>(a, smem);
}

DI void mla_item(const Params& p_in, int lat, int item, char* smem) {
  Params p = p_in; launder_params(p);
  const int wave = tidx() >> 6;
  AttnP a;
  a.sscale = 0.10206207261596577f * LOG2E;
  a.rope = (const float2*)(p.ws + W_ROPED); a.tq = 0; a.k2 = nullptr; a.ks2 = 0; a.grow = 0; a.c0 = 0; a.rpbs = nullptr; a.krlo = 0;
  if (lat) {
    int b = item >> 6, h = (item >> 3) & 7, qt = item & 7;
    int t = qt * 128 + wave * 32;
    int row = NCTX + b * 1024 + t;
    a.tq = t;
    a.q = (const u16*)(p.ws + W_QD) + (size_t)row * 768 + h * 96; a.qs = 768;
    a.k = (const u16*)(p.ws + W_KDL) + (size_t)b * 1536 * 768 + h * 96; a.ks = 768;
    a.vt = (const u16*)(p.ws + W_VDTL) + ((size_t)b * 512 + h * 64) * 1536; a.vs = 1536;
    a.ntiles = 24;
    a.o = (u16*)(p.ws + W_BRANCH) + (size_t)row * 2048 + 1536 + h * 64; a.os = 2048;
    attn_block<96, 1>(a, smem);
  } else {
    int b = item >> 4, h = (item >> 1) & 7, qt = item & 1;
    int row = b * 256 + qt * 128 + wave * 32;
    a.q = (const u16*)(p.ws + W_QD) + (size_t)row * 768 + h * 96; a.qs = 768;
    a.k = (const u16*)(p.ws + W_KDC) + (size_t)(b * 256) * 768 + h * 96; a.ks = 768;
    a.vt = (const u16*)(p.ws + W_VDTC) + ((size_t)b * 512 + h * 64) * 256; a.vs = 256;
    a.ntiles = 4;
    a.o = (u16*)(p.ws + W_BRANCH) + (size_t)row * 2048 + 1536 + h * 64; a.os = 2048;
    attn_block<96, 0>(a, smem);
  }
}

DI void hgrn_item(const Params& p_in, int l, int lat, int item, char* smem) {
  Params p = p_in; launder_params(p);
  const int tid = tidx();
  const int seq = item >> 3, vsl = item & 7;
  const int dir = seq & 1, h = (seq >> 1) & 3, b = seq >> 3;
  const int T = lat ? 1024 : 256;
  const int rowbase = lat ? NCTX + b * 1024 : b * 256;
  const int vi = tid & 15, kg = tid >> 4;
  float* qs = (float*)smem;
  float* fs = qs + 2 * 16 * 128;
  float* vsm = fs + 2 * 16 * 128;
  float* red = vsm + 2 * 16 * 16;
  f32x2 S2[4];
  if (lat) {
    const float* sp = p.state_hgrn + ((((size_t)(b * 2 + l) * 2 + dir) * 4 + h) * 128 + kg * 8) * 128 + vsl * 16 + vi;
#pragma unroll
    for (int kk = 0; kk < 4; ++kk) { S2[kk][0] = sp[(2 * kk) * 128]; S2[kk][1] = sp[(2 * kk + 1) * 128]; }
  } else {
#pragma unroll
    for (int kk = 0; kk < 4; ++kk) { S2[kk][0] = 0.f; S2[kk][1] = 0.f; }
  }
  const u16* pr = (const u16*)(p.ws + W_PROJ);
  const int ltok = tid >> 4, lk8 = (tid & 15) * 8;
  float lb[8];
  {
    const float* lp = (const float*)(p.ws + W_LBV) + (l * 2 + dir) * 512 + h * 128 + lk8;
#pragma unroll
    for (int i = 0; i < 8; ++i) lb[i] = lp[i];
  }
  const int fcol = (dir ? C_HFB : C_HFF) + h * 128 + lk8;
  const int qcol = C_HQ + h * 128 + lk8;
  const int vcol = C_HI + h * 128 + vsl * 16 + vi;
  const int nchunk = T >> 4;
  uint4 rq, rf;
  u16 rv;
  auto tokidx = [&](int c, int j) { int s = c * 16 + j; return dir ? (T - 1 - s) : s; };
  auto gload = [&](int c) {
    size_t ro = (size_t)(rowbase + tokidx(c, ltok)) * PW;
    rq = *(const uint4*)(pr + ro + qcol);
    rf = *(const uint4*)(pr + ro + fcol);
    rv = pr[ro + vcol];
  };
  auto sstore = [&](int buf) {
    float q8[8], f8[8];
    unpack8(rq, q8);
    unpack8(rf, f8);
    float* qd = qs + (buf * 16 + ltok) * 128 + lk8;
    float* fd = fs + (buf * 16 + ltok) * 128 + lk8;
#pragma unroll
    for (int i = 0; i < 8; ++i) {
      qd[i] = q8[i] * 0.08838834764831845f;
      fd[i] = lb[i] + (1.f - lb[i]) * sigmoidf_(f8[i]);
    }
    vsm[(buf * 16 + ltok) * 16 + vi] = bf2f(rv);
  };
  gload(0);
  sstore(0);
  __syncthreads();
  u16* obase = dir ? (u16*)(p.ws + W_OB) : (u16*)(p.ws + W_BRANCH);
  const size_t ostride = dir ? 512 : 2048;
#define HG_LD(J, FA, FB, QA, QB, VV)                                    \
  {                                                                     \
    const float* fp_ = fs + (buf * 16 + (J)) * 128 + kg * 8;            \
    const float* qp_ = qs + (buf * 16 + (J)) * 128 + kg * 8;            \
    FA = *(const float4*)(fp_); FB = *(const float4*)(fp_ + 4);         \
    QA = *(const float4*)(qp_); QB = *(const float4*)(qp_ + 4);         \
    VV = vsm[(buf * 16 + (J)) * 16 + vi];                               \
  }
#define HG_STEP(J, FA, FB, QA, QB, VV)                                  \
  {                                                                     \
    const f32x2 v2 = {VV, VV};                                          \
    const f32x2 f0 = {FA.x, FA.y}, f1 = {FA.z, FA.w}, f2 = {FB.x, FB.y}, f3 = {FB.z, FB.w}; \
    const f32x2 q0 = {QA.x, QA.y}, q1 = {QA.z, QA.w}, q2 = {QB.x, QB.y}, q3 = {QB.z, QB.w}; \
    S2[0] = f0 * (S2[0] - v2) + v2;                                     \
    S2[1] = f1 * (S2[1] - v2) + v2;                                     \
    S2[2] = f2 * (S2[2] - v2) + v2;                                     \
    S2[3] = f3 * (S2[3] - v2) + v2;                                     \
    f32x2 op2 = S2[0] * q0;                                             \
    op2 = S2[1] * q1 + op2;                                             \
    op2 = S2[2] * q2 + op2;                                             \
    op2 = S2[3] * q3 + op2;                                             \
    red[((J) * 16 + kg) * 16 + vi] = op2[0] + op2[1];                   \
  }
  for (int c = 0; c < nchunk; ++c) {
    const int buf = c & 1;
    const int cn = (c + 1 < nchunk) ? c + 1 : c;
    gload(cn);
    __builtin_amdgcn_sched_barrier(0);
    float4 fa[2][4], fb[2][4], qa[2][4], qb[2][4];
    float vv[2][4];
#pragma unroll
    for (int t = 0; t < 4; ++t) HG_LD(t, fa[0][t], fb[0][t], qa[0][t], qb[0][t], vv[0][t])
#pragma unroll
    for (int jb = 0; jb < 4; ++jb) {
      if (jb < 3) {
#pragma unroll
        for (int t = 0; t < 4; ++t)
          HG_LD(jb * 4 + 4 + t, fa[(jb + 1) & 1][t], fb[(jb + 1) & 1][t], qa[(jb + 1) & 1][t], qb[(jb + 1) & 1][t], vv[(jb + 1) & 1][t])
      }
      __builtin_amdgcn_sched_barrier(0);
#pragma unroll
      for (int t = 0; t < 4; ++t) HG_STEP(jb * 4 + t, fa[jb & 1][t], fb[jb & 1][t], qa[jb & 1][t], qb[jb & 1][t], vv[jb & 1][t])
      __builtin_amdgcn_sched_barrier(0);
    }
    __syncthreads();
    {
      float o = 0.f;
#pragma unroll
      for (int k2 = 0; k2 < 16; ++k2) o += red[(ltok * 16 + k2) * 16 + vi];
      obase[(size_t)(rowbase + tokidx(c, ltok)) * ostride + h * 128 + vsl * 16 + vi] = f2bf(o);
    }
    sstore(buf ^ 1);
    __syncthreads();
  }
#undef HG_LD
#undef HG_STEP
  if (!lat) {
    float* sp = p.out + O_STATE + ((((size_t)(b * 2 + l) * 2 + dir) * 4 + h) * 128 + kg * 8) * 128 + vsl * 16 + vi;
#pragma unroll
    for (int kk = 0; kk < 4; ++kk) { sp[(2 * kk) * 128] = S2[kk][0]; sp[(2 * kk + 1) * 128] = S2[kk][1]; }
  }
}

DI void hgrn_mfma_item(const Params& p_in, int l, int lat, int seq, char* smem) {
  Params p = p_in; launder_params(p);
  const int tid = tidx(), lane = tid & 63, wave = tid >> 6, r = lane & 31, g = lane >> 5;
  const int dir = seq & 1, h = (seq >> 1) & 3, b = seq >> 3;
  const int T = lat ? 1024 : 256;
  const int rowbase = lat ? NCTX + b * 1024 : b * 256;
  constexpr int QROW = 272, EROW = 80;
  char* QT = smem;
  char* KT = QT + 32 * QROW;
  char* KE = KT + 32 * QROW;
  char* VT = KE + 128 * EROW;
  float* EMID = (float*)(VT + 128 * EROW);
  float* DEC = EMID + 128;
  float* TOT = DEC + 128;
  const int kk = tid & 127, hf = tid >> 7;
  f32x16 S[4];
  if (lat) {
    const float* sp = p.state_hgrn + (((size_t)(b * 2 + l) * 2 + dir) * 4 + h) * 16384 + wave * 32 + r;
#pragma unroll
    for (int kb = 0; kb < 4; ++kb)
#pragma unroll
      for (int i = 0; i < 16; ++i) S[kb][i] = sp[(size_t)(kb * 32 + crow(i, g)) * 128];
  } else {
#pragma unroll
    for (int kb = 0; kb < 4; ++kb)
#pragma unroll
      for (int i = 0; i < 16; ++i) S[kb][i] = 0.f;
  }
  const u16* pr = (const u16*)(p.ws + W_PROJ);
  const float lbk = ((const float*)(p.ws + W_LBV))[(l * 2 + dir) * 512 + h * 128 + kk];
  const int fcol = (dir ? C_HFB : C_HFF) + h * 128 + kk;
  const int qcol = C_HQ + h * 128 + kk;
  const int vcol = C_HI + h * 128 + kk;
  const int nchunk = T >> 5;
  u16 rf[16], rq[16], rv[16];
#define HG_GLOAD(C)                                                                  \
  {                                                                                  \
    _Pragma("unroll") for (int i = 0; i < 16; ++i) {                                 \
      int sp_ = (C) * 32 + hf * 16 + i;                                              \
      int tok_ = dir ? (T - 1 - sp_) : sp_;                                          \
      const u16* rp_ = pr + (size_t)(rowbase + tok_) * PW;                           \
      rf[i] = rp_[fcol]; rq[i] = rp_[qcol]; rv[i] = rp_[vcol];                       \
    }                                                                                \
  }
  u16* obase = dir ? (u16*)(p.ws + W_OB) : (u16*)(p.ws + W_BRANCH);
  const size_t ostride = dir ? 512 : 2048;
  HG_GLOAD(0)
  for (int c = 0; c < nchunk; ++c) {
    float kv[16], ef[16], qv[16];
    unsigned vp[8];
    float run = 1.f;
#pragma unroll
    for (int i = 0; i < 16; ++i) {
      qv[i] = bf2f(rq[i]) * 0.08838834764831845f;
      if (i & 1) vp[i >> 1] |= ((unsigned)rv[i]) << 16; else vp[i >> 1] = (unsigned)rv[i];
    }
    if (hf) {
#pragma unroll
      for (int i = 0; i < 16; ++i) {
        const float f = lbk + (1.f - lbk) * sigmoidf_(bf2f(rf[i]));
        kv[i] = 1.f - f;
        run *= f; ef[i] = run;
      }
    } else {
#pragma unroll
      for (int i = 15; i >= 0; --i) {
        const float f = lbk + (1.f - lbk) * sigmoidf_(bf2f(rf[i]));
        kv[i] = 1.f - f;
        ef[i] = run; run *= f;
      }
    }
    TOT[hf * 128 + kk] = run;
    {
      const int cn = (c + 1 < nchunk) ? c + 1 : c;
      HG_GLOAD(cn)
    }
    __builtin_amdgcn_sched_barrier(0);
    __syncthreads();
    {
      const float F0 = TOT[kk], F1 = TOT[128 + kk];
      unsigned ke[8];
#pragma unroll
      for (int i = 0; i < 16; ++i) {
        const int tl = hf * 16 + i;
        const float inv = frcp(ef[i]);
        const float eq = hf ? ef[i] : inv;
        const float ek = hf ? inv : ef[i];
        const float ee = ek * F1;
        *(u16*)(QT + tl * QROW + kk * 2) = f2bf(qv[i] * eq);
        *(u16*)(KT + tl * QROW + kk * 2) = f2bf(kv[i] * ek);
        const float ken = kv[i] * ee;
        if (i & 1) ke[i >> 1] = pk2(__uint_as_float(ke[i >> 1]), ken);
        else ke[i >> 1] = __float_as_uint(ken);
      }
      *(uint4*)(KE + kk * EROW + hf * 32) = make_uint4(ke[0], ke[1], ke[2], ke[3]);
      *(uint4*)(KE + kk * EROW + hf * 32 + 16) = make_uint4(ke[4], ke[5], ke[6], ke[7]);
      *(uint4*)(VT + kk * EROW + hf * 32) = make_uint4(vp[0], vp[1], vp[2], vp[3]);
      *(uint4*)(VT + kk * EROW + hf * 32 + 16) = make_uint4(vp[4], vp[5], vp[6], vp[7]);
      if (hf == 0) { EMID[kk] = F0; DEC[kk] = F0 * F1; }
    }
    __syncthreads();
    f32x16 oacc;
#pragma unroll
    for (int i = 0; i < 16; ++i) oacc[i] = 0.f;
#pragma unroll
    for (int kb = 0; kb < 4; ++kb) {
#pragma unroll
      for (int s = 0; s < 2; ++s) {
        const float4 e0 = *(const float4*)(EMID + kb * 32 + 16 * s + 4 * g);
        const float4 e1 = *(const float4*)(EMID + kb * 32 + 16 * s + 8 + 4 * g);
        uint4 au;
        au.x = pk2(S[kb][8 * s + 0] * e0.x, S[kb][8 * s + 1] * e0.y);
        au.y = pk2(S[kb][8 * s + 2] * e0.z, S[kb][8 * s + 3] * e0.w);
        au.z = pk2(S[kb][8 * s + 4] * e1.x, S[kb][8 * s + 5] * e1.y);
        au.w = pk2(S[kb][8 * s + 6] * e1.z, S[kb][8 * s + 7] * e1.w);
        const char* qp = QT + r * QROW + (kb * 32 + 16 * s + 4 * g) * 2;
        bf16x4 lo = *(const bf16x4*)(qp);
        bf16x4 hi = *(const bf16x4*)(qp + 16);
        oacc = MFMA32(__builtin_bit_cast(bf16x8, au), __builtin_shufflevector(lo, hi, 0, 1, 2, 3, 4, 5, 6, 7), oacc);
      }
    }
    f32x16 sacc;
#pragma unroll
    for (int i = 0; i < 16; ++i) sacc[i] = 0.f;
#pragma unroll
    for (int ks = 0; ks < 8; ++ks) {
      bf16x8 ka = *(const bf16x8*)(KT + r * QROW + (16 * ks + 8 * g) * 2);
      bf16x8 qb = *(const bf16x8*)(QT + r * QROW + (16 * ks + 8 * g) * 2);
      sacc = MFMA32(ka, qb, sacc);
    }
#pragma unroll
    for (int i = 0; i < 16; ++i) sacc[i] = (crow(i, g) <= r) ? sacc[i] : 0.f;
#pragma unroll
    for (int s2 = 0; s2 < 2; ++s2) {
      uint4 pu;
      pu.x = pk2(sacc[8 * s2 + 0], sacc[8 * s2 + 1]); pu.y = pk2(sacc[8 * s2 + 2], sacc[8 * s2 + 3]);
      pu.z = pk2(sacc[8 * s2 + 4], sacc[8 * s2 + 5]); pu.w = pk2(sacc[8 * s2 + 6], sacc[8 * s2 + 7]);
      const char* vq = VT + (wave * 32 + r) * EROW + (16 * s2 + 4 * g) * 2;
      bf16x4 lo = *(const bf16x4*)(vq);
      bf16x4 hi = *(const bf16x4*)(vq + 16);
      oacc = MFMA32(__builtin_shufflevector(lo, hi, 0, 1, 2, 3, 4, 5, 6, 7), __builtin_bit_cast(bf16x8, pu), oacc);
    }
    {
      int sp_ = c * 32 + r;
      int tok_ = dir ? (T - 1 - sp_) : sp_;
      u16* op = obase + (size_t)(rowbase + tok_) * ostride + h * 128 + wave * 32 + 4 * g;
#pragma unroll
      for (int q4 = 0; q4 < 4; ++q4)
        *(uint2*)(op + 8 * q4) = pk4(oacc[4 * q4 + 0], oacc[4 * q4 + 1], oacc[4 * q4 + 2], oacc[4 * q4 + 3]);
    }
#pragma unroll
    for (int kb = 0; kb < 4; ++kb) {
#pragma unroll
      for (int q4 = 0; q4 < 4; ++q4) {
        const float4 d4 = *(const float4*)(DEC + kb * 32 + 8 * q4 + 4 * g);
        S[kb][4 * q4 + 0] *= d4.x; S[kb][4 * q4 + 1] *= d4.y; S[kb][4 * q4 + 2] *= d4.z; S[kb][4 * q4 + 3] *= d4.w;
      }
#pragma unroll
      for (int s = 0; s < 2; ++s) {
        bf16x8 ka = *(const bf16x8*)(KE + (kb * 32 + r) * EROW + (16 * s + 8 * g) * 2);
        bf16x8 vb = *(const bf16x8*)(VT + (wave * 32 + r) * EROW + (16 * s + 8 * g) * 2);
        S[kb] = MFMA32(ka, vb, S[kb]);
      }
    }
    __syncthreads();
  }
#undef HG_GLOAD
  if (!lat) {
    float* sp = p.out + O_STATE + (((size_t)(b * 2 + l) * 2 + dir) * 4 + h) * 16384 + wave * 32 + r;
#pragma unroll
    for (int kb = 0; kb < 4; ++kb)
#pragma unroll
      for (int i = 0; i < 16; ++i) __builtin_nontemporal_store(S[kb][i], sp + (size_t)(kb * 32 + crow(i, g)) * 128);
  }
}

DI void hgrn_lat_pc(const Params& p_in, int l, int seq, int role, char* smem) {
  Params p = p_in; launder_params(p);
  const int tid = tidx(), lane = tid & 63, wave = tid >> 6, r = lane & 31, g = lane >> 5;
  const int dir = seq & 1, h = (seq >> 1) & 3, b = seq >> 3;
  const int T = 1024;
  const int rowbase = NCTX + b * 1024;
  constexpr int QROW = 272, EROW = 80;
  constexpr int BUFB = 2 * 32 * QROW + 2 * 128 * EROW + 1024;
  float* TOT = (float*)(smem + 2 * BUFB);
  const int kk = tid & 127, hf = tid >> 7;
  const int nchunk = T >> 5;
  const u16* pr = (const u16*)(p.ws + W_PROJ);
  if (role == 1) {
    const float lbk = ((const float*)(p.ws + W_LBV))[(l * 2 + dir) * 512 + h * 128 + kk];
    const int fcol = (dir ? C_HFB : C_HFF) + h * 128 + kk;
    const int qcol = C_HQ + h * 128 + kk;
    const int vcol = C_HI + h * 128 + kk;
    u16 rf[16], rq[16], rv[16];
#define HG_GLOAD(C)                                                                  \
  {                                                                                  \
    _Pragma("unroll") for (int i = 0; i < 16; ++i) {                                 \
      int sp_ = (C) * 32 + hf * 16 + i;                                              \
      int tok_ = dir ? (T - 1 - sp_) : sp_;                                          \
      const u16* rp_ = pr + (size_t)(rowbase + tok_) * PW;                           \
      rf[i] = rp_[fcol]; rq[i] = rp_[qcol]; rv[i] = rp_[vcol];                       \
    }                                                                                \
  }
    HG_GLOAD(0)
    for (int c = 0; c <= nchunk; ++c) {
      if (c < nchunk) {
        char* QT = smem + (c & 1) * BUFB;
        char* KT = QT + 32 * QROW;
        char* KE = KT + 32 * QROW;
        char* VT = KE + 128 * EROW;
        float* EMID = (float*)(VT + 128 * EROW);
        float* DEC = EMID + 128;
        float kv[16], ef[16], qv[16];
        unsigned vp[8];
        float run = 1.f;
#pragma unroll
        for (int i = 0; i < 16; ++i) {
          qv[i] = bf2f(rq[i]) * 0.08838834764831845f;
          if (i & 1) vp[i >> 1] |= ((unsigned)rv[i]) << 16; else vp[i >> 1] = (unsigned)rv[i];
        }
        if (hf) {
#pragma unroll
          for (int i = 0; i < 16; ++i) {
            const float f = lbk + (1.f - lbk) * sigmoidf_(bf2f(rf[i]));
            kv[i] = 1.f - f;
            run *= f; ef[i] = run;
          }
        } else {
#pragma unroll
          for (int i = 15; i >= 0; --i) {
            const float f = lbk + (1.f - lbk) * sigmoidf_(bf2f(rf[i]));
            kv[i] = 1.f - f;
            ef[i] = run; run *= f;
          }
        }
        TOT[hf * 128 + kk] = run;
        {
          const int cn = (c + 1 < nchunk) ? c + 1 : c;
          HG_GLOAD(cn)
        }
        __builtin_amdgcn_sched_barrier(0);
        __syncthreads();
        {
          const float F0 = TOT[kk], F1 = TOT[128 + kk];
          unsigned ke[8];
#pragma unroll
          for (int i = 0; i < 16; ++i) {
            const int tl = hf * 16 + i;
            const float inv = frcp(ef[i]);
            const float eq = hf ? ef[i] : inv;
            const float ek = hf ? inv : ef[i];
            const float ee = ek * F1;
            *(u16*)(QT + tl * QROW + kk * 2) = f2bf(qv[i] * eq);
            *(u16*)(KT + tl * QROW + kk * 2) = f2bf(kv[i] * ek);
            const float ken = kv[i] * ee;
            if (i & 1) ke[i >> 1] = pk2(__uint_as_float(ke[i >> 1]), ken);
            else ke[i >> 1] = __float_as_uint(ken);
          }
          *(uint4*)(KE + kk * EROW + hf * 32) = make_uint4(ke[0], ke[1], ke[2], ke[3]);
          *(uint4*)(KE + kk * EROW + hf * 32 + 16) = make_uint4(ke[4], ke[5], ke[6], ke[7]);
          *(uint4*)(VT + kk * EROW + hf * 32) = make_uint4(vp[0], vp[1], vp[2], vp[3]);
          *(uint4*)(VT + kk * EROW + hf * 32 + 16) = make_uint4(vp[4], vp[5], vp[6], vp[7]);
          if (hf == 0) { EMID[kk] = F0; DEC[kk] = F0 * F1; }
        }
        __syncthreads();
      } else {
        __syncthreads();
        __syncthreads();
      }
    }
#undef HG_GLOAD
  } else {
    f32x16 S[4];
    {
      const float* sp = p.state_hgrn + (((size_t)(b * 2 + l) * 2 + dir) * 4 + h) * 16384 + wave * 32 + r;
#pragma unroll
      for (int kb = 0; kb < 4; ++kb)
#pragma unroll
        for (int i = 0; i < 16; ++i) S[kb][i] = sp[(size_t)(kb * 32 + crow(i, g)) * 128];
    }
    u16* obase = dir ? (u16*)(p.ws + W_OB) : (u16*)(p.ws + W_BRANCH);
    const size_t ostride = dir ? 512 : 2048;
    __syncthreads();
    __syncthreads();
    for (int c = 0; c < nchunk; ++c) {
      char* QT = smem + (c & 1) * BUFB;
      char* KT = QT + 32 * QROW;
      char* KE = KT + 32 * QROW;
      char* VT = KE + 128 * EROW;
      float* EMID = (float*)(VT + 128 * EROW);
      float* DEC = EMID + 128;
      f32x16 oacc;
#pragma unroll
      for (int i = 0; i < 16; ++i) oacc[i] = 0.f;
#pragma unroll
      for (int kb = 0; kb < 4; ++kb) {
#pragma unroll
        for (int s = 0; s < 2; ++s) {
          const float4 e0 = *(const float4*)(EMID + kb * 32 + 16 * s + 4 * g);
          const float4 e1 = *(const float4*)(EMID + kb * 32 + 16 * s + 8 + 4 * g);
          uint4 au;
          au.x = pk2(S[kb][8 * s + 0] * e0.x, S[kb][8 * s + 1] * e0.y);
          au.y = pk2(S[kb][8 * s + 2] * e0.z, S[kb][8 * s + 3] * e0.w);
          au.z = pk2(S[kb][8 * s + 4] * e1.x, S[kb][8 * s + 5] * e1.y);
          au.w = pk2(S[kb][8 * s + 6] * e1.z, S[kb][8 * s + 7] * e1.w);
          const char* qp = QT + r * QROW + (kb * 32 + 16 * s + 4 * g) * 2;
          bf16x4 lo = *(const bf16x4*)(qp);
          bf16x4 hi = *(const bf16x4*)(qp + 16);
          oacc = MFMA32(__builtin_bit_cast(bf16x8, au), __builtin_shufflevector(lo, hi, 0, 1, 2, 3, 4, 5, 6, 7), oacc);
        }
      }
      f32x16 sacc;
#pragma unroll
      for (int i = 0; i < 16; ++i) sacc[i] = 0.f;
#pragma unroll
      for (int ks = 0; ks < 8; ++ks) {
        bf16x8 ka = *(const bf16x8*)(KT + r * QROW + (16 * ks + 8 * g) * 2);
        bf16x8 qb = *(const bf16x8*)(QT + r * QROW + (16 * ks + 8 * g) * 2);
        sacc = MFMA32(ka, qb, sacc);
      }
#pragma unroll
      for (int i = 0; i < 16; ++i) sacc[i] = (crow(i, g) <= r) ? sacc[i] : 0.f;
      __syncthreads();
#pragma unroll
      for (int s2 = 0; s2 < 2; ++s2) {
        uint4 pu;
        pu.x = pk2(sacc[8 * s2 + 0], sacc[8 * s2 + 1]); pu.y = pk2(sacc[8 * s2 + 2], sacc[8 * s2 + 3]);
        pu.z = pk2(sacc[8 * s2 + 4], sacc[8 * s2 + 5]); pu.w = pk2(sacc[8 * s2 + 6], sacc[8 * s2 + 7]);
        const char* vq = VT + (wave * 32 + r) * EROW + (16 * s2 + 4 * g) * 2;
        bf16x4 lo = *(const bf16x4*)(vq);
        bf16x4 hi = *(const bf16x4*)(vq + 16);
        oacc = MFMA32(__builtin_shufflevector(lo, hi, 0, 1, 2, 3, 4, 5, 6, 7), __builtin_bit_cast(bf16x8, pu), oacc);
      }
      {
        int sp_ = c * 32 + r;
        int tok_ = dir ? (T - 1 - sp_) : sp_;
        u16* op = obase + (size_t)(rowbase + tok_) * ostride + h * 128 + wave * 32 + 4 * g;
#pragma unroll
        for (int q4 = 0; q4 < 4; ++q4)
          *(uint2*)(op + 8 * q4) = pk4(oacc[4 * q4 + 0], oacc[4 * q4 + 1], oacc[4 * q4 + 2], oacc[4 * q4 + 3]);
      }
#pragma unroll
      for (int kb = 0; kb < 4; ++kb) {
#pragma unroll
        for (int q4 = 0; q4 < 4; ++q4) {
          const float4 d4 = *(const float4*)(DEC + kb * 32 + 8 * q4 + 4 * g);
          S[kb][4 * q4 + 0] *= d4.x; S[kb][4 * q4 + 1] *= d4.y; S[kb][4 * q4 + 2] *= d4.z; S[kb][4 * q4 + 3] *= d4.w;
        }
#pragma unroll
        for (int s = 0; s < 2; ++s) {
          bf16x8 ka = *(const bf16x8*)(KE + (kb * 32 + r) * EROW + (16 * s + 8 * g) * 2);
          bf16x8 vb = *(const bf16x8*)(VT + (wave * 32 + r) * EROW + (16 * s + 8 * g) * 2);
          S[kb] = MFMA32(ka, vb, S[kb]);
        }
      }
      __syncthreads();
    }
  }
}

DI void hgpost_job(const Params& p_in, int l, int job) {
  Params p = p_in; launder_params(p);
  const int tid = tidx(), li = tid & 31;
  const float4 gn = *(const float4*)(p.hg_gain + l * 128 + li * 4);
  const u16* pr = (const u16*)(p.ws + W_PROJ);
  u16* br = (u16*)(p.ws + W_BRANCH);
  const u16* ob = (const u16*)(p.ws + W_OB);
  for (int pass = 0; pass < 16; ++pass) {
    int vec = pass * 8 + (tid >> 5);
    int row = job * 32 + (vec >> 2), h = vec & 3;
    float a[4], bb[4], gt[4];
    unpack4(*(const uint2*)(br + (size_t)row * 2048 + h * 128 + li * 4), a);
    unpack4(*(const uint2*)(ob + (size_t)row * 512 + h * 128 + li * 4), bb);
    unpack4(*(const uint2*)(pr + (size_t)row * PW + C_HG + h * 128 + li * 4), gt);
    float o0 = a[0] + bb[0], o1 = a[1] + bb[1], o2 = a[2] + bb[2], o3 = a[3] + bb[3];
    float ss = o0 * o0 + o1 * o1 + o2 * o2 + o3 * o3;
#pragma unroll
    for (int o = 16; o >= 1; o >>= 1) ss += shx(ss, o);
    float rstd = rsqrtf(ss * (1.f / 128.f) + EPS);
    *(uint2*)(br + (size_t)row * 2048 + h * 128 + li * 4) =
        pk4(o0 * rstd * gn.x * siluf_(gt[0]), o1 * rstd * gn.y * siluf_(gt[1]), o2 * rstd * gn.z * siluf_(gt[2]),
            o3 * rstd * gn.w * siluf_(gt[3]));
  }
}

DI void inproj_tile(const Params& p_in, int idx, char* smem) {
  Params p = p_in; launder_params(p);
  const int mt = idx & 63, nt = idx >> 6;
  f32x16 acc[2][2];
  zero_acc<2, 2>(acc);
  gemm_core<2, 2>((const u16*)(p.ws + W_H) + (size_t)mt * 128 * 1024, 1024, (const u16*)(p.ws + W_IN) + (size_t)nt * 128 * 1024, 1024,
                  PW - nt * 128, 1024, acc, smem);
  u16* pr = (u16*)(p.ws + W_PROJ);
  EPI_LOOP(2, 2, acc, {
    int col = nt * 128 + ec;
    if (col < PW) {
      size_t o = (size_t)(mt * 128 + er) * PW + col;
      pr[o] = f2bf(v0); pr[o + PW] = f2bf(v1); pr[o + 2 * PW] = f2bf(v2); pr[o + 3 * PW] = f2bf(v3);
    }
  })
}

DI void qb_tile(const Params& p_in, int l, int idx, char* smem) {
  Params p = p_in; launder_params(p);
  const size_t wo = l ? W_SET2 : 0;
  const int mt = idx & 63, nt = idx >> 6;
  f32x16 acc[2][2];
  zero_acc<2, 2>(acc);
  gemm_core<2, 2>((const u16*)(p.ws + W_AQ) + (size_t)mt * 128 * 256, 256, (const u16*)(p.ws + wo + W_QB) + (size_t)nt * 128 * 256, 256, 128, 256,
                  acc, smem);
  u16* qd = (u16*)(p.ws + W_QD);
  EPI_LOOP(2, 2, acc, {
    size_t o = (size_t)(mt * 128 + er) * 768 + nt * 128 + ec;
    qd[o] = f2bf(v0); qd[o + 768] = f2bf(v1); qd[o + 2 * 768] = f2bf(v2); qd[o + 3 * 768] = f2bf(v3);
  })
}

DI void kvb_tile(const Params& p_in, int l, int idx, char* smem) {
  Params p = p_in; launder_params(p);
  const size_t wo = l ? W_SET2 : 0;
  const int mt = idx % 80, h = idx / 80;
  f32x16 acc[2][2];
  zero_acc<2, 2>(acc);
  gemm_core<2, 2>((const u16*)(p.ws + W_ACKV) + (size_t)mt * 128 * 128, 128, (const u16*)(p.ws + wo + W_KVB) + (size_t)h * 128 * 128, 128, 128, 128,
                  acc, smem);
  const int r0 = mt * 128;
  u16* kd; u16* vt; size_t vstride; int key0;
  if (r0 < NCTX) {
    int b = r0 >> 8; key0 = r0 & 255;
    kd = (u16*)(p.ws + W_KDC) + (size_t)r0 * 768;
    vt = (u16*)(p.ws + W_VDTC) + (size_t)b * 512 * 256; vstride = 256;
  } else if (r0 < NTOK) {
    int rr = r0 - NCTX; int b = rr >> 10; key0 = 512 + (rr & 1023);
    kd = (u16*)(p.ws + W_KDL) + ((size_t)b * 1536 + key0) * 768;
    vt = (u16*)(p.ws + W_VDTL) + (size_t)b * 512 * 1536; vstride = 1536;
  } else {
    int rr = r0 - NTOK; int b = rr >> 9; key0 = rr & 511;
    kd = (u16*)(p.ws + W_KDL) + ((size_t)b * 1536 + key0) * 768;
    vt = (u16*)(p.ws + W_VDTL) + (size_t)b * 512 * 1536; vstride = 1536;
  }
  EPI_LOOP(2, 2, acc, {
    if (ec < 64) {
      size_t o = (size_t)er * 768 + h * 96 + ec;
      kd[o] = f2bf(v0); kd[o + 768] = f2bf(v1); kd[o + 2 * 768] = f2bf(v2); kd[o + 3 * 768] = f2bf(v3);
    } else {
      *(uint2*)(vt + (size_t)(h * 64 + ec - 64) * vstride + key0 + er) = pk4(v0, v1, v2, v3);
    }
  })
}

DI void merge_tile(const Params& p_in, int idx, char* smem) {
  Params p = p_in; launder_params(p);
  const int mt = idx & 63, nt = idx >> 6;
  f32x16 tot[2][1], bo[2][1], gg[2][1];
  zero_acc<2, 1>(tot);
#pragma unroll 1
  for (int n = 0; n < 4; ++n) {
    zero_acc<2, 1>(bo);
    zero_acc<2, 1>(gg);
    gemm_core<2, 1>((const u16*)(p.ws + W_BRANCH) + (size_t)mt * 128 * 2048 + n * 512, 2048,
                    (const u16*)(p.ws + W_BR) + ((size_t)n * 1024 + nt * 64) * 512, 512, 64, 512, bo, smem);
    gemm_core<2, 1>((const u16*)(p.ws + W_H) + (size_t)mt * 128 * 1024, 1024,
                    (const u16*)(p.ws + W_IN) + ((size_t)C_GATES + n * 1024 + nt * 64) * 1024, 1024, 64, 1024, gg, smem);
#pragma unroll
    for (int mb = 0; mb < 2; ++mb)
#pragma unroll
      for (int i = 0; i < 16; ++i) tot[mb][0][i] += sigmoidf_(gg[mb][0][i]) * bo[mb][0][i];
  }
  u16* mg = (u16*)(p.ws + W_MERGED);
  EPI_LOOP(2, 1, tot, {
    size_t o = (size_t)(mt * 128 + er) * 1024 + nt * 64 + ec;
    mg[o] = f2bf(v0); mg[o + 1024] = f2bf(v1); mg[o + 2048] = f2bf(v2); mg[o + 3072] = f2bf(v3);
  })
}

DI void resid_tile(const Params& p_in, int l, int idx, const u16* A, int lda, const u16* Wt, int K, int which, char* smem) {
  Params p = p_in; launder_params(p);
  const int mt = idx & 63, nt = idx >> 6;
  f32x16 acc[2][2];
  zero_acc<2, 2>(acc);
  gemm_core<2, 2>(A + (size_t)mt * 128 * lda, lda, Wt + (size_t)nt * 128 * K, K, 128, K, acc, smem);
  const int cond = cond_of_row(mt * 128);
  const float* gt = (const float*)(p.ws + W_MOD) + (size_t)(l * 5 + cond) * 6144 + which * 1024;
  EPI_LOOP(2, 2, acc, {
    int col = nt * 128 + ec;
    float gv = gt[col];
    float* xp = p.out + (size_t)(mt * 128 + er) * 1024 + col;
    xp[0] += gv * v0; xp[1024] += gv * v1; xp[2048] += gv * v2; xp[3072] += gv * v3;
  })
}

DI void ffn1_tile(const Params& p_in, int idx, char* smem) {
  Params p = p_in; launder_params(p);
  const int mt = idx & 63, nt = idx >> 6;
  f32x16 acc[2][2];
  zero_acc<2, 2>(acc);
  gemm_core<2, 2>((const u16*)(p.ws + W_H) + (size_t)mt * 128 * 1024, 1024, (const u16*)(p.ws + W_FFI) + (size_t)nt * 128 * 1024, 1024, 128, 1024,
                  acc, smem);
  u16* hd = (u16*)(p.ws + W_HIDDEN);
  const int lane = tidx() & 63, wave = tidx() >> 6, wm = wave >> 1, wn = wave & 1, g = lane >> 5;
#pragma unroll
  for (int mb = 0; mb < 2; ++mb)
#pragma unroll
    for (int i = 0; i < 16; ++i) {
      float av = acc[mb][0][i], gv = acc[mb][1][i];
      int row = mt * 128 + wm * 64 + mb * 32 + crow(i, g);
      int col = (nt * 2 + wn) * 32 + (lane & 31);
      hd[(size_t)row * FFH + col] = f2bf(siluf_(gv) * av);
    }
}


DI void inproj_phase512(const Params& p_in, int l, int bid, int G, char* smem) {
  Params p = p_in; launder_params(p);
  const size_t wo = l ? W_SET2 : 0;
  u32x4 ra[4], rb[4];
  bool pre = false;
  for (int idx = bid; idx < 32 * 21; idx += G) {
    const int mt = idx & 31, nt = idx >> 5;
    const int idn = idx + G;
    const bool has_next = idn < 32 * 21;
    const int mtn = has_next ? (idn & 31) : mt, ntn = has_next ? (idn >> 5) : nt;
    const GDesc512<4> c = make_gdesc<4>((const u16*)(p.ws + W_H) + (size_t)mt * 256 * 1024, 1024,
                                        (const u16*)(p.ws + wo + W_IN) + (size_t)nt * 256 * 1024, 1024, PW - nt * 256, 1024);
    const GDesc512<4> n = make_gdesc<4>((const u16*)(p.ws + W_H) + (size_t)mtn * 256 * 1024, 1024,
                                        (const u16*)(p.ws + wo + W_IN) + (size_t)ntn * 256 * 1024, 1024, PW - ntn * 256, 1024);
    f32x16 acc[2][4];
    zero_acc<2, 4>(acc);
    gemm512_chain<2, 4>(c, n, has_next, pre, ra, rb, acc, smem);
    pre = has_next;
    u16* pr = (u16*)(p.ws + W_PROJ);
    EPI512(2, 4, acc, {
      int col = nt * 256 + ec;
      if (col < PW) {
        size_t o = (size_t)(mt * 256 + er) * PW + col;
        pr[o] = f2bf(v0); pr[o + PW] = f2bf(v1); pr[o + 2 * PW] = f2bf(v2); pr[o + 3 * PW] = f2bf(v3);
      }
    })
  }
}

DI void ffn1_phase512(const Params& p_in, int l, int bid, int G, char* smem) {
  Params p = p_in; launder_params(p);
  const size_t wo = l ? W_SET2 : 0;
  u32x4 ra[4], rb[4];
  bool pre = false;
  for (int idx = bid; idx < 32 * 22; idx += G) {
    const int mt = idx & 31, nt = idx >> 5;
    const int idn = idx + G;
    const bool has_next = idn < 32 * 22;
    const int mtn = has_next ? (idn & 31) : mt, ntn = has_next ? (idn >> 5) : nt;
    const GDesc512<4> c = make_gdesc<4>((const u16*)(p.ws + W_H) + (size_t)mt * 256 * 1024, 1024,
                                        (const u16*)(p.ws + wo + W_FFI) + (size_t)nt * 256 * 1024, 1024, 256, 1024);
    const GDesc512<4> n = make_gdesc<4>((const u16*)(p.ws + W_H) + (size_t)mtn * 256 * 1024, 1024,
                                        (const u16*)(p.ws + wo + W_FFI) + (size_t)ntn * 256 * 1024, 1024, 256, 1024);
    f32x16 acc[2][4];
    zero_acc<2, 4>(acc);
    gemm512_chain<2, 4>(c, n, has_next, pre, ra, rb, acc, smem);
    pre = has_next;
    u16* hd = (u16*)(p.ws + W_HIDDEN);
    const int t5 = tidx512();
    const int lane = t5 & 63, wave = t5 >> 6, wm = wave >> 1, wn = wave & 1, g = lane >> 5;
#pragma unroll
    for (int mb = 0; mb < 2; ++mb)
#pragma unroll
      for (int pr2 = 0; pr2 < 2; ++pr2)
#pragma unroll
        for (int i = 0; i < 16; ++i) {
          float av = acc[mb][2 * pr2][i], gv = acc[mb][2 * pr2 + 1][i];
          int row = mt * 256 + wm * 64 + mb * 32 + crow(i, g);
          int col = (nt * 4 + wn * 2 + pr2) * 32 + (lane & 31);
          hd[(size_t)row * FFH + col] = f2bf(siluf_(gv) * av);
        }
  }
}

DI void resid512(const Params& p_in, int l, int idx, const u16* A, int lda, const u16* Wt, int K, int which, char* smem) {
  Params p = p_in; launder_params(p);
  const int mt = idx & 31, nt = idx >> 5;
  f32x16 acc[2][2];
  zero_acc<2, 2>(acc);
  gemm512_core<2, 2>(A + (size_t)mt * 256 * lda, lda, Wt + (size_t)nt * 128 * K, K, 128, K, acc, smem);
  const int cond = cond_of_row(mt * 256);
  const float* gt = (const float*)(p.ws + W_MOD) + (size_t)(l * 5 + cond) * 6144 + which * 1024;
  EPI512(2, 2, acc, {
    int col = nt * 128 + ec;
    float gv = gt[col];
    float* xp = p.out + (size_t)(mt * 256 + er) * 1024 + col;
    xp[0] += gv * v0; xp[1024] += gv * v1; xp[2048] += gv * v2; xp[3072] += gv * v3;
  })
}

DI void merge512(const Params& p_in, int l, int idx, char* smem) {
  Params p = p_in; launder_params(p);
  const size_t wo = l ? W_SET2 : 0;
  const int mt = idx & 31, nt = idx >> 5;
  unsigned totp[2][2][8], sgp[2][2][8];
#pragma unroll
  for (int mb = 0; mb < 2; ++mb)
#pragma unroll
    for (int nb = 0; nb < 2; ++nb)
#pragma unroll
      for (int i = 0; i < 8; ++i) totp[mb][nb][i] = 0u;
  u32x4 ra[4], rb[2];
  const u16* Hrow = (const u16*)(p.ws + W_H) + (size_t)mt * 256 * 1024;
  const u16* Brow = (const u16*)(p.ws + W_BRANCH) + (size_t)mt * 256 * 2048;
  const u16* Wg = (const u16*)(p.ws + wo + W_IN) + ((size_t)C_GATES + nt * 128) * 1024;
  const u16* Wb = (const u16*)(p.ws + wo + W_BR) + (size_t)(nt * 128) * 512;
#pragma unroll 1
  for (int n = 0; n < 4; ++n) {
    const GDesc512<2> dg = make_gdesc<2>(Hrow, 1024, Wg + (size_t)n * 1024 * 1024, 1024, 128, 1024);
    const GDesc512<2> db = make_gdesc<2>(Brow + n * 512, 2048, Wb + (size_t)n * 1024 * 512, 512, 128, 512);
    const int n1 = n < 3 ? n + 1 : n;
    const GDesc512<2> dg1 = make_gdesc<2>(Hrow, 1024, Wg + (size_t)n1 * 1024 * 1024, 1024, 128, 1024);
    {
      f32x16 gg[2][2];
      zero_acc<2, 2>(gg);
      gemm512_chain<2, 2>(dg, db, true, n > 0, ra, rb, gg, smem);
#pragma unroll
      for (int mb = 0; mb < 2; ++mb)
#pragma unroll
        for (int nb = 0; nb < 2; ++nb)
#pragma unroll
          for (int i = 0; i < 8; ++i) sgp[mb][nb][i] = pk2(sigmoidf_(gg[mb][nb][2 * i]), sigmoidf_(gg[mb][nb][2 * i + 1]));
    }
    {
      f32x16 bo[2][2];
      zero_acc<2, 2>(bo);
      gemm512_chain<2, 2>(db, dg1, n < 3, true, ra, rb, bo, smem);
#pragma unroll
      for (int mb = 0; mb < 2; ++mb)
#pragma unroll
        for (int nb = 0; nb < 2; ++nb)
#pragma unroll
          for (int i = 0; i < 8; ++i) {
            const unsigned t = totp[mb][nb][i], g2 = sgp[mb][nb][i];
            const float lo = __uint_as_float(t << 16) + __uint_as_float(g2 << 16) * bo[mb][nb][2 * i];
            const float hi = __uint_as_float(t & 0xffff0000u) + __uint_as_float(g2 & 0xffff0000u) * bo[mb][nb][2 * i + 1];
            totp[mb][nb][i] = pk2(lo, hi);
          }
    }
  }
  u16* mg = (u16*)(p.ws + W_MERGED);
  {
    const int t5 = tidx512();
    const int lane = t5 & 63, wave = t5 >> 6, wm = wave >> 1, wn = wave & 1, g = lane >> 5;
#pragma unroll
    for (int mb = 0; mb < 2; ++mb)
#pragma unroll
      for (int nb = 0; nb < 2; ++nb)
#pragma unroll
        for (int i = 0; i < 8; ++i) {
          const int row = mt * 256 + wm * 64 + mb * 32 + crow(2 * i, g);
          const int col = nt * 128 + wn * 64 + nb * 32 + (lane & 31);
          const unsigned t = totp[mb][nb][i];
          mg[(size_t)row * 1024 + col] = (u16)(t & 0xffffu);
          mg[(size_t)(row + 1) * 1024 + col] = (u16)(t >> 16);
        }
  }
}


constexpr int NWCONV = 16 * 37 + 16 * 22 + 44 * 4 + 4 * 8 * 4 + 16 * 4 + 4 * 3 + 2 * 4;
DI void wconv_job(const Params& p_in, int l, int j, char* sm) {
  Params p = p_in; launder_params(p);
  char* wb = p.ws + (l ? W_SET2 : 0);
  const int e0 = 16 * 37, e1 = e0 + 16 * 22, e2 = e1 + 44 * 4, e3 = e2 + 4 * 8 * 4, e4 = e3 + 16 * 4, e5 = e4 + 4 * 3;
  if (j < e0) {
    wtrans_tile(p.w_in + (size_t)l * 1024 * INW, 1024, INW, j / 37, j % 37, (u16*)(wb + W_IN), false, sm);
  } else if (j < e1) {
    int t = j - e0;
    wtrans_tile(p.w_ffn_in + (size_t)l * 1024 * 5632, 1024, 5632, t / 22, t % 22, (u16*)(wb + W_FFI), true, sm);
  } else if (j < e2) {
    int t = j - e1;
    wtrans_tile(p.w_ffn_out + (size_t)l * FFH * 1024, FFH, 1024, t >> 2, t & 3, (u16*)(wb + W_FFO), false, sm);
  } else if (j < e3) {
    int t = j - e2;
    int n = t >> 5, tt = t & 31;
    wtrans_tile(p.w_branch + ((size_t)l * 4 + n) * 512 * 1024, 512, 1024, tt >> 2, tt & 3, (u16*)(wb + W_BR) + (size_t)n * 1024 * 512, false, sm);
  } else if (j < e4) {
    int t = j - e3;
    wtrans_tile(p.w_out + (size_t)l * 1024 * 1024, 1024, 1024, t >> 2, t & 3, (u16*)(wb + W_OUT), false, sm);
  } else if (j < e5) {
    int t = j - e4;
    wtrans_tile(p.ml_w_q_b + (size_t)l * 256 * 768, 256, 768, t / 3, t % 3, (u16*)(wb + W_QB), false, sm);
  } else {
    int t = j - e5;
    wtrans_tile(p.ml_w_kv_b + (size_t)l * 128 * 1024, 128, 1024, t >> 2, t & 3, (u16*)(wb + W_KVB), false, sm);
  }
}

#define XB_TMO      128
#define XB_XCNT(j)  (256  + 64 * (j))
#define XB_XSUB(j)  (1280 + 64 * (j))
#define XB_XGEN(j)  (2304 + 64 * (j))
#define XB_TOP      3328
#define XB_TOPGEN   3392
#define XCD_BAR_WORDS 3456
#define XB_SPIN_CAP (1u << 18)
#define LAS __attribute__((address_space(3)))
DI unsigned xb_ld(unsigned* p) { return __hip_atomic_load(p, __ATOMIC_RELAXED, __HIP_MEMORY_SCOPE_AGENT); }
DI unsigned xb_add(unsigned* p, unsigned v) { return __hip_atomic_fetch_add(p, v, __ATOMIC_RELAXED, __HIP_MEMORY_SCOPE_AGENT); }
DI unsigned xb_xcc_id() { return (unsigned)__builtin_amdgcn_s_getreg((3 << 11) | 20) & 0xFu; }
#define XB_SPIN(cond, bar) do { unsigned _sp = 0; while (cond) { __builtin_amdgcn_s_sleep(1); \
    if ((++_sp & 255u) == 0u) { if (xb_ld(&(bar)[XB_TMO])) break; if (_sp > XB_SPIN_CAP) { atomicAdd(&(bar)[XB_TMO], 1u); break; } } } } while (0)
struct XcdBarrier { unsigned* bar; unsigned x; volatile LAS unsigned* st; };
DI XcdBarrier xcd_barrier_post(unsigned* bar, volatile LAS unsigned* st) {
  XcdBarrier b; b.bar = bar; b.x = xb_xcc_id(); b.st = st;
  if (threadIdx.x == 0) (void)xb_add(&bar[XB_XCNT(b.x)], 1u);
  return b;
}
DI void xcd_barrier_complete(unsigned* bar, unsigned x, unsigned& nloc, unsigned& nx) {
  const unsigned G = gridDim.x * gridDim.y * gridDim.z;
  unsigned sum, cnt, mine, sp = 0u;
  for (;;) {
    sum = 0u; cnt = 0u; mine = 0u;
#pragma unroll
    for (unsigned j = 0; j < 16; ++j) { const unsigned c = xb_ld(&bar[XB_XCNT(j)]); sum += c; cnt += (c > 0u) ? 1u : 0u; mine = (j == x) ? c : mine; }
    if (sum == G) break;
    __builtin_amdgcn_s_sleep(1);
    if ((++sp & 255u) == 0u) { if (xb_ld(&bar[XB_TMO])) break; if (sp > XB_SPIN_CAP) { atomicAdd(&bar[XB_TMO], 1u); break; } }
  }
  nloc = mine > 0u ? mine : 1u; nx = cnt > 0u ? cnt : 1u;
}
DI void xcd_barrier(const XcdBarrier& b) {
  asm volatile("s_waitcnt vmcnt(0)" ::: "memory");
  __syncthreads();
  if (threadIdx.x == 0) {
    unsigned* bar = b.bar;
    __builtin_amdgcn_s_waitcnt(0);
    unsigned nloc = b.st[0], nx = b.st[1];
    if (nloc == 0u) { xcd_barrier_complete(bar, b.x, nloc, nx); b.st[0] = nloc; b.st[1] = nx; }
    const unsigned old = xb_add(&bar[XB_XSUB(b.x)], 1u);
    const unsigned gen = old / nloc;
    if (old + 1u == (gen + 1u) * nloc) {
      __builtin_amdgcn_fence(__ATOMIC_RELEASE, "agent");
      asm volatile("s_waitcnt vmcnt(0)" ::: "memory");
      const unsigned og = xb_add(&bar[XB_TOP], 1u);
      const unsigned tg = og / nx;
      if (og + 1u == (tg + 1u) * nx) xb_add(&bar[XB_TOPGEN], 1u);
      else XB_SPIN(xb_ld(&bar[XB_TOPGEN]) == tg, bar);
      __builtin_amdgcn_fence(__ATOMIC_ACQUIRE, "agent");
      xb_add(&bar[XB_XGEN(b.x)], 1u);
      asm volatile("s_waitcnt vmcnt(0)" ::: "memory");
    } else {
      XB_SPIN(xb_ld(&bar[XB_XGEN(b.x)]) == gen, bar);
      __builtin_amdgcn_fence(__ATOMIC_ACQUIRE, "agent");
      asm volatile("s_waitcnt vmcnt(0)" ::: "memory");
    }
  }
  __syncthreads();
}


DI int launder_s(int x) { asm volatile("" : "+s"(x)); return x; }
#define SMH (smem + launder_s(sub) * SMEM_HALF)
#define WFILL2(ci, LAYER, lo1, n1, lo2, n2)                                      \
  {                                                                              \
    int* fctr_ = (int*)(p.ws + W_CTR) + (ci);                                    \
    for (;;) {                                                                   \
      if (threadIdx.x == 0) s_next = atomicAdd(fctr_, 2);                        \
      __syncthreads();                                                           \
      const int ff_ = s_next + sub;                                              \
      __syncthreads();                                                           \
      if (ff_ >= (n1) + (n2)) break;                                             \
      wconv_job(p, (LAYER), ff_ < (n1) ? (lo1) + ff_ : (lo2) + (ff_ - (n1)), SMH); \
    }                                                                            \
  }

__global__ void __launch_bounds__(512, 2) fwd_megakernel(Params p) {
  cg::grid_group grid = cg::this_grid();
  __shared__ __attribute__((aligned(16))) char smem[SMEM_BYTES];
  __shared__ int s_next;
  __shared__ uint4 xb_words;
  const int G = gridDim.x, bid = blockIdx.x;
  const int sub = __builtin_amdgcn_readfirstlane((int)(threadIdx.x >> 8));
  if (threadIdx.x == 0) xb_words = make_uint4(0u, 0u, 0u, 0u);
  __syncthreads();
  const XcdBarrier xb = xcd_barrier_post((unsigned*)(p.ws + W_BAR), (volatile LAS unsigned*)&xb_words);

  for (int l = 0; l < 2; ++l) {
    if (l == 0) {
      const int q0 = 192, q1 = q0 + 64, q2 = q1 + 612, q3 = q2 + 18;
      int* ctr = (int*)(p.ws + W_CTR) + 14;
      for (;;) {
        if (threadIdx.x == 0) s_next = atomicAdd(ctr, 2);
        __syncthreads();
        const int j = s_next + sub;
        __syncthreads();
        if (j >= q3) break;
        if (j < q0) adaln_job(p, j / 96, j % 96, SMH);
        else if (j < q1) cache_job(p, 0, j - q0, SMH);
        else if (j < q2) { const int t = j - q1; wconv_job(p, 0, t < 592 ? t : 1312 + (t - 592), SMH); }
        else misc_job(p, j - q2);
      }
    } else {
      for (int j0 = bid * 2; j0 < 64 + 2048; j0 += 2 * G) {
        const int j = j0 + sub;
        if (j < 64) cache_job(p, 1, j, SMH);
        else norm_job(p, 1, 0, j - 64, false);
      }
    }
    if (p.ws == nullptr) grid.sync();
    xcd_barrier(xb);
    if (l == 0) {
      for (int j0 = bid * 2; j0 < 2048; j0 += 2 * G) norm_job(p, 0, 0, j0 + sub, true);
      xcd_barrier(xb);
    }
    inproj_phase512(p, l, bid, G, smem);
    if (l == 0) WFILL2(4, 0, 1120, 192, 592, 148)
    else        WFILL2(5, 1, 1120, 192, 592, 148)
    xcd_barrier(xb);
    for (int j0 = bid * 2; j0 < 512; j0 += 2 * G) prep_job(p, l, ((j0 >> 2) << 1) + sub, (j0 >> 1) & 1, SMH);
    xcd_barrier(xb);
    {
      const int a0 = 64, a1 = a0 + 256, a2 = a1 + 256, a3 = a2 + 128, a4 = a3 + 640, a5 = a4 + 384, a6 = a5 + 0, a7 = a6 + 0;
      int* ctr = (int*)(p.ws + W_CTR) + l * 2;
      for (;;) {
        if (threadIdx.x == 0) s_next = atomicAdd(ctr, 2);
        __syncthreads();
        const int j = s_next + sub;
        __syncthreads();
        if (j >= a7) break;
        if (j < a0) hgrn_lat_pc(p, l, j >> 1, sub, smem);
        else if (j < a1) gqa_item(p, 1, j - a0, SMH);
        else if (j < a2) na_lat_item(p, l, j - a1, SMH);
        else if (j < a3) hgrn_mfma_item(p, l, 0, j - a2, SMH);
        else if (j < a4) kvb_tile(p, l, j - a3, SMH);
        else if (j < a5) qb_tile(p, l, j - a4, SMH);
        else if (j < a6) gqa_item(p, 0, j - a5, SMH);
        else na_ctx_item(p, j - a6, SMH);
      }
      if (l == 0) WFILL2(6, 0, 740, 204, 0, 0)
      if (l == 0) WFILL2(7, 1, 164, 216, 0, 0)
      if (l == 1) WFILL2(8, 1, 740, 100, 0, 0)
    }
    xcd_barrier(xb);
    {
      int* ctr = (int*)(p.ws + W_CTR) + l * 2 + 1;
      for (;;) {
        if (threadIdx.x == 0) s_next = atomicAdd(ctr, 2);
        __syncthreads();
        const int j = s_next + sub;
        __syncthreads();
        if (j >= 1280) break;
        if (j < 256) mla_item(p, 1, j, SMH);
        else if (j < 512) hgpost_job(p, l, j - 256);
        else if (j < 768) mla_item(p, 0, j - 512, SMH);
        else if (j < 1024) gqa_item(p, 0, j - 768, SMH);
        else na_ctx_item(p, j - 1024, SMH);
      }
      if (l == 0) WFILL2(9, 0, 944, 176, 0, 0)
      if (l == 0) WFILL2(10, 1, 0, 164, 0, 0)
      if (l == 1) WFILL2(11, 1, 840, 104, 944, 176)
    }
    xcd_barrier(xb);
    for (int j = bid; j < 256; j += G) merge512(p, l, j, smem);
    xcd_barrier(xb);
    for (int j = bid; j < 256; j += G)
      resid512(p, l, j, (const u16*)(p.ws + W_MERGED), 1024, (const u16*)(p.ws + (l ? W_SET2 : 0) + W_OUT), 1024, 2, smem);
    xcd_barrier(xb);
    for (int j0 = bid * 2; j0 < 2048; j0 += 2 * G) norm_job(p, l, 1, j0 + sub, false);
    xcd_barrier(xb);
    ffn1_phase512(p, l, bid, G, smem);
    if (l == 0) WFILL2(12, 1, 380, 212, 1312, 20)
    xcd_barrier(xb);
    for (int j = bid; j < 256; j += G)
      resid512(p, l, j, (const u16*)(p.ws + W_HIDDEN), FFH, (const u16*)(p.ws + (l ? W_SET2 : 0) + W_FFO), FFH, 5, smem);
    xcd_barrier(xb);
  }
  for (int j0 = bid * 2; j0 < 2048; j0 += 2 * G) final_norm_job(p, j0 + sub);
}

extern "C" void kernel_launch(void* const* d_in, const int* in_sizes, int n_in, void* d_out, int out_size, void* d_ws,
                              size_t ws_size, hipStream_t stream) {
  static int grid_blocks = 0;
  if (!grid_blocks) {
    int dev = 0, cus = 0, per_cu = 0;
    hipGetDevice(&dev);
    hipDeviceGetAttribute(&cus, hipDeviceAttributeMultiprocessorCount, dev);
    hipOccupancyMaxActiveBlocksPerMultiprocessor(&per_cu, fwd_megakernel, 512, 0);
    per_cu = 1;
    grid_blocks = cus * per_cu;
  }
  if (ws_size < W_TOTAL) { fprintf(stderr, "workspace too small: %zu < %zu\n", ws_size, (size_t)W_END); return; }
  Params p{};
  const float** f = (const float**)&p;
  for (int i = 0; i < 28; ++i) f[i] = (const float*)d_in[i];
  p.out = (float*)d_out;
  p.ws = (char*)d_ws;
  hipMemsetAsync((char*)d_ws + W_CTR, 0, 64 + 3456 * 4, stream);
  void* args[] = {&p};
  hipError_t e = hipLaunchCooperativeKernel((void*)fwd_megakernel, dim3(grid_blocks), dim3(512), args, 0, stream);
  if (e != hipSuccess) fprintf(stderr, "cooperative launch failed: %s (grid %d)\n", hipGetErrorString(e), grid_blocks);
}
```

```cpp
#include <hip/hip_runtime.h>
#include <hip/hip_cooperative_groups.h>
#include <stdint.h>
#include <cstdio>
namespace cg = cooperative_groups;

typedef unsigned short u16;
typedef __attribute__((ext_vector_type(8))) short bf16x8;
typedef __attribute__((ext_vector_type(4))) short bf16x4;
typedef __attribute__((ext_vector_type(16))) float f32x16;
typedef __attribute__((ext_vector_type(2))) float f32x2;
typedef __attribute__((ext_vector_type(4))) float f32v4;
typedef __attribute__((ext_vector_type(4))) unsigned u32x4;
typedef __attribute__((ext_vector_type(2))) __bf16 bfx2;
#define DI __device__ __forceinline__
#define MFMA32(a, b, c) __builtin_amdgcn_mfma_f32_32x32x16_bf16((a), (b), (c), 0, 0, 0)

constexpr int D = 1024;
constexpr int NTOK = 8192;
constexpr int NCTX = 4096;
constexpr int PW = 5280;
constexpr int INW = 9376;
constexpr int FFH = 2816;
constexpr int C_HQ = 0, C_HFF = 512, C_HFB = 1024, C_HI = 1536, C_HG = 2048, C_GQ = 2560, C_GK = 3072, C_GV = 3200,
              C_NQ = 3328, C_NK = 3840, C_NV = 4352, C_MQA = 4864, C_MKVA = 5120, C_MKR = 5248, C_GATES = 5280;
constexpr float EPS = 1e-6f;
constexpr float LOG2E = 1.4426950408889634f;

constexpr size_t O_X = 0;
constexpr size_t O_STATE = 8388608;
constexpr size_t O_GQK = 12582912;
constexpr size_t O_GQV = 13631488;
constexpr size_t O_NAK = 14680064;
constexpr size_t O_NAV = 18874368;
constexpr size_t O_CKV = 23068672;
constexpr size_t O_KR = 24117248;

constexpr size_t W_IN = 0;
constexpr size_t W_FFI = W_IN + (size_t)INW * 1024 * 2;
constexpr size_t W_FFO = W_FFI + (size_t)5632 * 1024 * 2;
constexpr size_t W_BR = W_FFO + (size_t)1024 * FFH * 2;
constexpr size_t W_OUT = W_BR + (size_t)4 * 1024 * 512 * 2;
constexpr size_t W_QB = W_OUT + (size_t)1024 * 1024 * 2;
constexpr size_t W_KVB = W_QB + (size_t)768 * 256 * 2;
constexpr size_t W_MOD = W_KVB + (size_t)1024 * 128 * 2;
constexpr size_t W_LBV = W_MOD + (size_t)2 * 5 * 6144 * 4;
constexpr size_t W_ROPEB = W_LBV + (size_t)2 * 2 * 512 * 4;
constexpr size_t W_ROPED = W_ROPEB + (size_t)1024 * 32 * 8;
constexpr size_t W_PROJ = W_ROPED + (size_t)1024 * 16 * 8;
constexpr size_t W_H = W_PROJ + (size_t)NTOK * PW * 2;
constexpr size_t W_BRANCH = W_H + (size_t)NTOK * 1024 * 2;
constexpr size_t W_OB = W_BRANCH + (size_t)NTOK * 2048 * 2;
constexpr size_t W_QBF = W_OB + (size_t)NTOK * 512 * 2;
constexpr size_t W_KBC = W_QBF + (size_t)NTOK * 512 * 2;
constexpr size_t W_KBL = W_KBC + (size_t)4096 * 128 * 2;
constexpr size_t W_VBTC = W_KBL + (size_t)4 * 1536 * 128 * 2;
constexpr size_t W_VBTL = W_VBTC + (size_t)16 * 128 * 256 * 2;
constexpr size_t W_NKC = W_VBTL + (size_t)4 * 128 * 1536 * 2;
constexpr size_t W_NVTC = W_NKC + (size_t)4 * 512 * 512 * 2;
constexpr size_t W_NVTL = W_NVTC + (size_t)16 * 512 * 256 * 2;
constexpr size_t W_AQ = W_NVTL + (size_t)4 * 512 * 1536 * 2;
constexpr size_t W_ACKV = W_AQ + (size_t)NTOK * 256 * 2;
constexpr size_t W_QD = W_ACKV + (size_t)10240 * 128 * 2;
constexpr size_t W_KDC = W_QD + (size_t)NTOK * 768 * 2;
constexpr size_t W_KDL = W_KDC + (size_t)4096 * 768 * 2;
constexpr size_t W_VDTC = W_KDL + (size_t)4 * 1536 * 768 * 2;
constexpr size_t W_VDTL = W_VDTC + (size_t)16 * 512 * 256 * 2;
constexpr size_t W_END = W_VDTL + (size_t)4 * 512 * 1536 * 2;
constexpr size_t W_CTR = W_END;
constexpr size_t W_BAR = W_END + 64;
constexpr size_t W_SET2 = W_BAR + 3456 * 4 + 64;
constexpr size_t W_TOTAL = W_SET2 + W_MOD;
constexpr size_t W_MERGED = W_OB;
constexpr size_t W_HIDDEN = W_PROJ;

constexpr int SMEM_HALF = 73728;
constexpr int SMEM_BYTES = 2 * SMEM_HALF;

struct Params {
  const float *x_prompt, *x_sample, *state_hgrn, *cgk, *cgv, *cnk, *cnv, *cckv, *ckr, *c, *c_ctx, *w_ada, *b_ada, *w_in,
      *lb_logits, *hg_gain, *gq_q_gain, *gq_k_gain, *na_rpb, *ml_q_a_gain, *ml_kv_a_gain, *ml_w_q_b, *ml_w_kv_b, *w_branch,
      *w_out, *w_ffn_in, *w_ffn_out, *final_gain;
  float* out;
  char* ws;
};

DI int tidx() { int t = threadIdx.x & 255; asm volatile("" : "+v"(t)); return t; }
DI int tidx512() { int t = threadIdx.x; asm volatile("" : "+v"(t)); return t; }
DI void launder_params(Params& q) { size_t z = 0; asm volatile("" : "+s"(z)); q.ws += z; q.out += z; }

DI float bf2f(u16 b) { return __uint_as_float(((unsigned)b) << 16); }
DI unsigned pk2(float a, float b) {
  f32x2 v = {a, b};
  bfx2 r = __builtin_convertvector(v, bfx2);
  return __builtin_bit_cast(unsigned, r);
}
DI u16 f2bf(float a) { return (u16)(pk2(a, 0.f) & 0xffffu); }
DI uint2 pk4(float a, float b, float c, float d) { uint2 r; r.x = pk2(a, b); r.y = pk2(c, d); return r; }
DI float frcp(float x) { return __builtin_amdgcn_rcpf(x); }
DI float sigmoidf_(float x) { return frcp(1.f + __expf(-x)); }
DI float siluf_(float x) { return x * frcp(1.f + __expf(-x)); }
DI void unpack4(uint2 u, float* f) {
  f[0] = __uint_as_float(u.x << 16); f[1] = __uint_as_float(u.x & 0xffff0000u);
  f[2] = __uint_as_float(u.y << 16); f[3] = __uint_as_float(u.y & 0xffff0000u);
}
DI void unpack8(uint4 u, float* f) {
  f[0] = __uint_as_float(u.x << 16); f[1] = __uint_as_float(u.x & 0xffff0000u);
  f[2] = __uint_as_float(u.y << 16); f[3] = __uint_as_float(u.y & 0xffff0000u);
  f[4] = __uint_as_float(u.z << 16); f[5] = __uint_as_float(u.z & 0xffff0000u);
  f[6] = __uint_as_float(u.w << 16); f[7] = __uint_as_float(u.w & 0xffff0000u);
}

DI float shx(float v, int m) {
  int iv = __float_as_int(v), r;
  switch (m) {
    case 1:  r = __builtin_amdgcn_ds_swizzle(iv, 0x041f); break;
    case 2:  r = __builtin_amdgcn_ds_swizzle(iv, 0x081f); break;
    case 4:  r = __builtin_amdgcn_ds_swizzle(iv, 0x101f); break;
    case 8:  r = __builtin_amdgcn_ds_swizzle(iv, 0x201f); break;
    case 16: r = __builtin_amdgcn_ds_swizzle(iv, 0x401f); break;
    default: {
      int lid = __builtin_amdgcn_mbcnt_hi(~0u, __builtin_amdgcn_mbcnt_lo(~0u, 0u));
      asm volatile("" : "+v"(lid));
      r = __builtin_amdgcn_ds_bpermute((lid ^ 32) << 2, iv);
    } break;
  }
  return __int_as_float(r);
}
DI float4 ldnt4(const float* p) { f32v4 t = __builtin_nontemporal_load((const f32v4*)p); return make_float4(t[0], t[1], t[2], t[3]); }
DI void stnt4(float* p, float4 v) { f32v4 t = {v.x, v.y, v.z, v.w}; __builtin_nontemporal_store(t, (f32v4*)p); }
DI int crow(int i, int g) { return (i & 3) + 8 * (i >> 2) + 4 * g; }
DI int cond_of_row(int row) { return row < NCTX ? 0 : 1 + ((row - NCTX) >> 10); }

template <int MB, int NB>
DI void gemm_core(const u16* __restrict__ A, int lda, const u16* __restrict__ B, int ldb, int nvalid, int K,
                  f32x16 (&acc)[MB][NB], char* smem) {
  constexpr int BM = 64 * MB, BN = 64 * NB;
  constexpr int LROW = 144;
  constexpr int ACH = MB * 2, BCH = NB * 2;
  char* As = smem;
  char* Bs = smem + 2 * BM * LROW;
  const int tid = tidx(), lane = tid & 63, wave = tid >> 6, wm = wave >> 1, wn = wave & 1;
  u32x4 ra0[ACH], rb0[BCH], ra1[ACH], rb1[BCH];
  const int crow_ = tid >> 3, ckc = tid & 7;
  const u16* ap[ACH];
  const u16* bp[BCH];
#pragma unroll
  for (int i = 0; i < ACH; ++i) ap[i] = A + (size_t)(crow_ + 32 * i) * lda + ckc * 8;
#pragma unroll
  for (int i = 0; i < BCH; ++i) {
    int r = crow_ + 32 * i;
    r = r < nvalid ? r : nvalid - 1;
    bp[i] = B + (size_t)r * ldb + ckc * 8;
  }
  int nk = K >> 6;
  asm volatile("" : "+s"(nk));
  char* const as_w = As + crow_ * LROW + ckc * 16;
  char* const bs_w = Bs + crow_ * LROW + ckc * 16;
  const char* const a_rd = As + (wm * 32 * MB + (lane & 31)) * LROW + (lane >> 5) * 16;
  const char* const b_rd = Bs + (wn * 32 * NB + (lane & 31)) * LROW + (lane >> 5) * 16;
#define GLOAD(RA, RB, K0)                                                               \
  {                                                                                     \
    _Pragma("unroll") for (int i = 0; i < ACH; ++i) RA[i] = *(const u32x4*)(ap[i] + (K0)); \
    _Pragma("unroll") for (int i = 0; i < BCH; ++i) RB[i] = *(const u32x4*)(bp[i] + (K0)); \
  }
#define SSTORE(RA, RB, BUF)                                                                              \
  {                                                                                                      \
    _Pragma("unroll") for (int i = 0; i < ACH; ++i) *(u32x4*)(as_w + ((BUF) * BM + 32 * i) * LROW) = RA[i]; \
    _Pragma("unroll") for (int i = 0; i < BCH; ++i) *(u32x4*)(bs_w + ((BUF) * BN + 32 * i) * LROW) = RB[i]; \
  }
#define COMPUTE(BUF)                                                                                  \
  {                                                                                                   \
    bf16x8 af[4][MB], bfr[4][NB];                                                                     \
    _Pragma("unroll") for (int s = 0; s < 4; ++s) {                                                   \
      _Pragma("unroll") for (int mb = 0; mb < MB; ++mb)                                               \
        af[s][mb] = *(const bf16x8*)(a_rd + ((BUF) * BM + mb * 32) * LROW + s * 32);                  \
      _Pragma("unroll") for (int nb = 0; nb < NB; ++nb)                                               \
        bfr[s][nb] = *(const bf16x8*)(b_rd + ((BUF) * BN + nb * 32) * LROW + s * 32);                 \
    }                                                                                                 \
    _Pragma("unroll") for (int s = 0; s < 4; ++s)                                                     \
      _Pragma("unroll") for (int mb = 0; mb < MB; ++mb)                                               \
        _Pragma("unroll") for (int nb = 0; nb < NB; ++nb)                                             \
          acc[mb][nb] = MFMA32(af[s][mb], bfr[s][nb], acc[mb][nb]);                                   \
  }
  GLOAD(ra0, rb0, 0)
  GLOAD(ra1, rb1, 64)
  SSTORE(ra0, rb0, 0)
  __syncthreads();
  for (int kt = 0; kt < nk; kt += 2) {
    const int t2 = (kt + 2 < nk) ? kt + 2 : nk - 2;
    GLOAD(ra0, rb0, t2 << 6)
    __builtin_amdgcn_sched_barrier(0);
    COMPUTE(0)
    SSTORE(ra1, rb1, 1)
    __syncthreads();
    GLOAD(ra1, rb1, (t2 + 1) << 6)
    __builtin_amdgcn_sched_barrier(0);
    COMPUTE(1)
    SSTORE(ra0, rb0, 0)
    __syncthreads();
  }
#undef GLOAD
#undef SSTORE
#undef COMPUTE
}

template <int MB, int NB>
DI void zero_acc(f32x16 (&acc)[MB][NB]) {
#pragma unroll
  for (int mb = 0; mb < MB; ++mb)
#pragma unroll
    for (int nb = 0; nb < NB; ++nb)
#pragma unroll
      for (int i = 0; i < 16; ++i) acc[mb][nb][i] = 0.f;
}

#define EPI_LOOP(MB, NB, acc, BODY)                                              \
  {                                                                              \
    const int lane_ = tidx() & 63, wave_ = tidx() >> 6;                \
    const int wm_ = wave_ >> 1, wn_ = wave_ & 1, g_ = lane_ >> 5;                \
    _Pragma("unroll") for (int mb = 0; mb < MB; ++mb)                            \
    _Pragma("unroll") for (int nb = 0; nb < NB; ++nb)                            \
    _Pragma("unroll") for (int q4 = 0; q4 < 4; ++q4) {                           \
      const int er = wm_ * 32 * MB + mb * 32 + 8 * q4 + 4 * g_;                  \
      const int ec = wn_ * 32 * NB + nb * 32 + (lane_ & 31);                     \
      const float v0 = acc[mb][nb][4 * q4 + 0], v1 = acc[mb][nb][4 * q4 + 1];    \
      const float v2 = acc[mb][nb][4 * q4 + 2], v3 = acc[mb][nb][4 * q4 + 3];    \
      BODY                                                                       \
    }                                                                            \
  }


template <int MB, int NB>
DI void gemm512_core(const u16* __restrict__ A, int lda, const u16* __restrict__ B, int ldb, int nvalid, int K,
                     f32x16 (&acc)[MB][NB], char* smem) {
  constexpr int BM = 128 * MB, BN = 64 * NB;
  constexpr int LROW = 144;
  constexpr int ACH = BM / 64, BCH = BN / 64;
  char* As = smem;
  char* Bs = smem + 2 * BM * LROW;
  const int tid = tidx512(), lane = tid & 63, wave = tid >> 6, wm = wave >> 1, wn = wave & 1;
  u32x4 ra[ACH], rb[BCH];
  const int crow_ = tid >> 3, ckc = tid & 7;
  const unsigned aoff = (unsigned)(crow_ * lda + ckc * 8) * 2u;
  unsigned boff[BCH];
#pragma unroll
  for (int i = 0; i < BCH; ++i) {
    int r = crow_ + 64 * i;
    r = r < nvalid ? r : nvalid - 1;
    boff[i] = (unsigned)(r * ldb + ckc * 8) * 2u;
  }
  const char* const Ab = (const char*)A;
  const char* const Bb = (const char*)B;
  const size_t astep = (size_t)64 * lda * 2;
  int nk = K >> 6;
  asm volatile("" : "+s"(nk));
  char* const as_w = As + crow_ * LROW + ckc * 16;
  char* const bs_w = Bs + crow_ * LROW + ckc * 16;
  const char* const a_rd = As + (wm * 32 * MB + (lane & 31)) * LROW + (lane >> 5) * 16;
  const char* const b_rd = Bs + (wn * 32 * NB + (lane & 31)) * LROW + (lane >> 5) * 16;
#define GLOAD5(K0)                                                                      \
  {                                                                                     \
    _Pragma("unroll") for (int i = 0; i < ACH; ++i) ra[i] = *(const u32x4*)(Ab + (size_t)i * astep + (size_t)(K0) * 2 + aoff); \
    _Pragma("unroll") for (int i = 0; i < BCH; ++i) rb[i] = *(const u32x4*)(Bb + (size_t)(K0) * 2 + boff[i]); \
  }
#define SSTORE5(BUF)                                                                                     \
  {                                                                                                      \
    _Pragma("unroll") for (int i = 0; i < ACH; ++i) *(u32x4*)(as_w + ((BUF) * BM + 64 * i) * LROW) = ra[i]; \
    _Pragma("unroll") for (int i = 0; i < BCH; ++i) *(u32x4*)(bs_w + ((BUF) * BN + 64 * i) * LROW) = rb[i]; \
  }
  GLOAD5(0)
  SSTORE5(0)
  GLOAD5(64)
  __syncthreads();
  for (int kt = 0; kt < nk; ++kt) {
    const int buf = kt & 1;
    const int t2 = (kt + 2 < nk) ? kt + 2 : nk - 1;
    const size_t k2 = (size_t)(t2 << 6) * 2;
#pragma unroll
    for (int s = 0; s < 4; ++s) {
      bf16x8 af[MB], bfr[NB];
#pragma unroll
      for (int mb = 0; mb < MB; ++mb) af[mb] = *(const bf16x8*)(a_rd + (buf * BM + mb * 32) * LROW + s * 32);
#pragma unroll
      for (int nb = 0; nb < NB; ++nb) bfr[nb] = *(const bf16x8*)(b_rd + (buf * BN + nb * 32) * LROW + s * 32);
      if (s < ACH) {
        *(u32x4*)(as_w + ((buf ^ 1) * BM + 64 * s) * LROW) = ra[s];
        ra[s] = *(const u32x4*)(Ab + (size_t)s * astep + k2 + aoff);
      }
      if (s < BCH) {
        *(u32x4*)(bs_w + ((buf ^ 1) * BN + 64 * s) * LROW) = rb[s];
        rb[s] = *(const u32x4*)(Bb + k2 + boff[s]);
      }
      __builtin_amdgcn_sched_barrier(0);
#pragma unroll
      for (int mb = 0; mb < MB; ++mb)
#pragma unroll
        for (int nb = 0; nb < NB; ++nb) acc[mb][nb] = MFMA32(af[mb], bfr[nb], acc[mb][nb]);
    }
    __syncthreads();
  }
#undef GLOAD5
#undef SSTORE5
}


template <int NB>
struct GDesc512 { const char* Ab; const char* Bb; size_t astep; unsigned aoff; unsigned boff[NB]; int nk; };

template <int NB>
DI GDesc512<NB> make_gdesc(const u16* A, int lda, const u16* B, int ldb, int nvalid, int K) {
  const int tid = tidx512();
  const int crow_ = tid >> 3, ckc = tid & 7;
  GDesc512<NB> d;
  d.Ab = (const char*)A; d.Bb = (const char*)B;
  d.astep = (size_t)64 * lda * 2;
  d.aoff = (unsigned)(crow_ * lda + ckc * 8) * 2u;
#pragma unroll
  for (int i = 0; i < NB; ++i) {
    int r = crow_ + 64 * i;
    r = r < nvalid ? r : nvalid - 1;
    d.boff[i] = (unsigned)(r * ldb + ckc * 8) * 2u;
  }
  d.nk = K >> 6;
  return d;
}

template <int MB, int NB>
DI void gemm512_chain(const GDesc512<NB>& c, const GDesc512<NB>& n, bool has_next, bool preloaded,
                      u32x4 (&ra)[2 * MB], u32x4 (&rb)[NB], f32x16 (&acc)[MB][NB], char* smem) {
  constexpr int BM = 128 * MB, BN = 64 * NB;
  constexpr int LROW = 144;
  constexpr int ACH = 2 * MB, BCH = NB;
  char* As = smem;
  char* Bs = smem + 2 * BM * LROW;
  const int tid = tidx512(), lane = tid & 63, wave = tid >> 6, wm = wave >> 1, wn = wave & 1;
  const int crow_ = tid >> 3, ckc = tid & 7;
  int nk = c.nk;
  asm volatile("" : "+s"(nk));
  char* const as_w = As + crow_ * LROW + ckc * 16;
  char* const bs_w = Bs + crow_ * LROW + ckc * 16;
  const char* const a_rd = As + (wm * 32 * MB + (lane & 31)) * LROW + (lane >> 5) * 16;
  const char* const b_rd = Bs + (wn * 32 * NB + (lane & 31)) * LROW + (lane >> 5) * 16;
  if (!preloaded) {
#pragma unroll
    for (int i = 0; i < ACH; ++i) ra[i] = *(const u32x4*)(c.Ab + (size_t)i * c.astep + c.aoff);
#pragma unroll
    for (int i = 0; i < BCH; ++i) rb[i] = *(const u32x4*)(c.Bb + c.boff[i]);
#pragma unroll
    for (int i = 0; i < ACH; ++i) *(u32x4*)(as_w + (64 * i) * LROW) = ra[i];
#pragma unroll
    for (int i = 0; i < BCH; ++i) *(u32x4*)(bs_w + (64 * i) * LROW) = rb[i];
#pragma unroll
    for (int i = 0; i < ACH; ++i) ra[i] = *(const u32x4*)(c.Ab + (size_t)i * c.astep + 128 + c.aoff);
#pragma unroll
    for (int i = 0; i < BCH; ++i) rb[i] = *(const u32x4*)(c.Bb + 128 + c.boff[i]);
    __syncthreads();
  }
#define CH_ITER(BUF, SAB, SASTEP, SAOFF, SBB, SBOFF, K2)                                                   \
  {                                                                                                        \
    _Pragma("unroll") for (int s = 0; s < 4; ++s) {                                                        \
      bf16x8 af[MB], bfr[NB];                                                                              \
      _Pragma("unroll") for (int mb = 0; mb < MB; ++mb)                                                    \
        af[mb] = *(const bf16x8*)(a_rd + ((BUF) * BM + mb * 32) * LROW + s * 32);                          \
      _Pragma("unroll") for (int nb = 0; nb < NB; ++nb)                                                    \
        bfr[nb] = *(const bf16x8*)(b_rd + ((BUF) * BN + nb * 32) * LROW + s * 32);                         \
      if (s < ACH) {                                                                                       \
        *(u32x4*)(as_w + (((BUF) ^ 1) * BM + 64 * s) * LROW) = ra[s];                                      \
        ra[s] = *(const u32x4*)((SAB) + (size_t)s * (SASTEP) + (K2) + (SAOFF));                            \
      }                                                                                                    \
      if (s < BCH) {                                                                                       \
        *(u32x4*)(bs_w + (((BUF) ^ 1) * BN + 64 * s) * LROW) = rb[s];                                      \
        rb[s] = *(const u32x4*)((SBB) + (K2) + (SBOFF)[s]);                                                \
      }                                                                                                    \
      __builtin_amdgcn_sched_barrier(0);                                                                   \
      _Pragma("unroll") for (int mb = 0; mb < MB; ++mb)                                                    \
        _Pragma("unroll") for (int nb = 0; nb < NB; ++nb) acc[mb][nb] = MFMA32(af[mb], bfr[nb], acc[mb][nb]); \
    }                                                                                                      \
    __syncthreads();                                                                                       \
  }
  for (int kt = 0; kt < nk - 2; ++kt) {
    const int buf = kt & 1;
    const size_t k2 = (size_t)(kt + 2) * 128;
    CH_ITER(buf, c.Ab, c.astep, c.aoff, c.Bb, c.boff, k2)
  }
  {
    const char* tAb = has_next ? n.Ab : c.Ab;
    const char* tBb = has_next ? n.Bb : c.Bb;
    const size_t tastep = has_next ? n.astep : c.astep;
    const unsigned taoff = has_next ? n.aoff : c.aoff;
    unsigned tboff[NB];
#pragma unroll
    for (int i = 0; i < NB; ++i) tboff[i] = has_next ? n.boff[i] : c.boff[i];
    const size_t k2a = has_next ? (size_t)0 : (size_t)(nk - 1) * 128;
    const size_t k2b = has_next ? (size_t)128 : (size_t)(nk - 1) * 128;
    CH_ITER(0, tAb, tastep, taoff, tBb, tboff, k2a)
    CH_ITER(1, tAb, tastep, taoff, tBb, tboff, k2b)
  }
#undef CH_ITER
}

#define EPI512(MB, NB, acc, BODY)                                                \
  {                                                                              \
    const int t5_ = tidx512();                                                   \
    const int lane_ = t5_ & 63, wave_ = t5_ >> 6;                                \
    const int wm_ = wave_ >> 1, wn_ = wave_ & 1, g_ = lane_ >> 5;                \
    _Pragma("unroll") for (int mb = 0; mb < MB; ++mb)                            \
    _Pragma("unroll") for (int nb = 0; nb < NB; ++nb)                            \
    _Pragma("unroll") for (int q4 = 0; q4 < 4; ++q4) {                           \
      const int er = wm_ * 32 * MB + mb * 32 + 8 * q4 + 4 * g_;                  \
      const int ec = wn_ * 32 * NB + nb * 32 + (lane_ & 31);                     \
      const float v0 = acc[mb][nb][4 * q4 + 0], v1 = acc[mb][nb][4 * q4 + 1];    \
      const float v2 = acc[mb][nb][4 * q4 + 2], v3 = acc[mb][nb][4 * q4 + 3];    \
      BODY                                                                       \
    }                                                                            \
  }

DI int ffn_perm(int n) {
  int j = n < FFH ? n : n - FFH;
  return (j >> 5) * 64 + (j & 31) + (n < FFH ? 0 : 32);
}
DI void wtrans_tile(const float* __restrict__ src, int K, int N, int kt, int nt4, u16* __restrict__ dst, bool perm, char* smem) {
  float(*s)[65] = (float(*)[65])smem;
  const int tid = tidx();
  const int k0 = kt * 64;
  float4 v[4][4];
#pragma unroll
  for (int q = 0; q < 4; ++q)
#pragma unroll
    for (int i = 0; i < 4; ++i) {
      int r = (tid >> 4) + 16 * i, c4 = tid & 15;
      int n = (nt4 * 4 + q) * 64 + c4 * 4;
      v[q][i] = make_float4(0.f, 0.f, 0.f, 0.f);
      if (n < N) v[q][i] = ldnt4(src + (size_t)(k0 + r) * N + n);
    }
#pragma unroll
  for (int q = 0; q < 4; ++q) {
    const int n0 = (nt4 * 4 + q) * 64;
#pragma unroll
    for (int i = 0; i < 4; ++i) {
      int r = (tid >> 4) + 16 * i, c4 = tid & 15;
      s[r][c4 * 4 + 0] = v[q][i].x; s[r][c4 * 4 + 1] = v[q][i].y; s[r][c4 * 4 + 2] = v[q][i].z; s[r][c4 * 4 + 3] = v[q][i].w;
    }
    __syncthreads();
#pragma unroll
    for (int j = 0; j < 2; ++j) {
      int ch = tid + 256 * j;
      int n = ch >> 3, kc = ch & 7;
      if (n0 + n < N) {
        int dn = perm ? ffn_perm(n0 + n) : (n0 + n);
        uint4 o;
        o.x = pk2(s[kc * 8 + 0][n], s[kc * 8 + 1][n]);
        o.y = pk2(s[kc * 8 + 2][n], s[kc * 8 + 3][n]);
        o.z = pk2(s[kc * 8 + 4][n], s[kc * 8 + 5][n]);
        o.w = pk2(s[kc * 8 + 6][n], s[kc * 8 + 7][n]);
        *(uint4*)(dst + (size_t)dn * K + k0 + kc * 8) = o;
      }
    }
    __syncthreads();
  }
}

template <bool F32SRC>
DI void tr32x128(const void* src, size_t sstride, u16* dst, size_t dstride, char* smem) {
  u16(*s)[136] = (u16(*)[136])smem;
  const int tid = tidx();
  const int r = tid >> 3, c16 = (tid & 7) * 16;
  if (F32SRC) {
    const float* sp = (const float*)src + (size_t)r * sstride + c16;
#pragma unroll
    for (int i = 0; i < 4; ++i) {
      float4 v = ldnt4(sp + 4 * i);
      *(uint2*)(&s[r][c16 + 4 * i]) = pk4(v.x, v.y, v.z, v.w);
    }
  } else {
    const u16* sp = (const u16*)src + (size_t)r * sstride + c16;
    uint4 a = *(const uint4*)(sp), b = *(const uint4*)(sp + 8);
    *(uint4*)(&s[r][c16]) = a;
    *(uint4*)(&s[r][c16 + 8]) = b;
  }
  __syncthreads();
#pragma unroll
  for (int j = 0; j < 2; ++j) {
    int ch = tid + 256 * j;
    int col = ch >> 2, kc = ch & 3;
    uint4 o;
    o.x = (unsigned)s[kc * 8 + 0][col] | ((unsigned)s[kc * 8 + 1][col] << 16);
    o.y = (unsigned)s[kc * 8 + 2][col] | ((unsigned)s[kc * 8 + 3][col] << 16);
    o.z = (unsigned)s[kc * 8 + 4][col] | ((unsigned)s[kc * 8 + 5][col] << 16);
    o.w = (unsigned)s[kc * 8 + 6][col] | ((unsigned)s[kc * 8 + 7][col] << 16);
    *(uint4*)(dst + (size_t)col * dstride + kc * 8) = o;
  }
  __syncthreads();
}

DI void adaln_job(const Params& p_in, int l, int jg, char* smem) {
  Params p = p_in; launder_params(p);
  float* sc = (float*)smem;
  float* red = sc + 5 * 1024;
  const int tid = tidx(), lane = tid & 63, wave = tid >> 6;
  for (int idx = tid; idx < 5 * 1024; idx += 256) {
    int c = idx >> 10, k = idx & 1023;
    float v = (c == 0) ? p.c_ctx[k] : p.c[(c - 1) * 1024 + k];
    sc[idx] = siluf_(v);
  }
  __syncthreads();
  const int j = jg * 64 + lane;
  float acc[5] = {0.f, 0.f, 0.f, 0.f, 0.f};
  const float* wp = p.w_ada + ((size_t)l * 1024 + wave * 256) * 6144 + j;
  const float* sp = sc + wave * 256;
#pragma unroll 32
  for (int k = 0; k < 256; ++k) {
    float wv = __builtin_nontemporal_load(wp + (size_t)k * 6144);
#pragma unroll
    for (int c = 0; c < 5; ++c) acc[c] += sp[c * 1024 + k] * wv;
  }
#pragma unroll
  for (int c = 0; c < 5; ++c) red[(wave * 5 + c) * 64 + lane] = acc[c];
  __syncthreads();
  for (int t2 = tid; t2 < 320; t2 += 256) {
    int c = t2 >> 6, ln = t2 & 63;
    float v = red[(0 * 5 + c) * 64 + ln] + red[(1 * 5 + c) * 64 + ln] + red[(2 * 5 + c) * 64 + ln] + red[(3 * 5 + c) * 64 + ln];
    v += p.b_ada[l * 6144 + jg * 64 + ln];
    ((float*)(p.ws + W_MOD))[(size_t)(l * 5 + c) * 6144 + jg * 64 + ln] = v;
  }
  __syncthreads();
}

DI void misc_job(const Params& p_in, int j) {
  Params p = p_in; launder_params(p);
  const int tid = tidx();
  if (j < 16) {
    float2* rb = (float2*)(p.ws + W_ROPEB);
    float2* rd = (float2*)(p.ws + W_ROPED);
    for (int idx = tid; idx < 64 * 32; idx += 256) {
      int t = j * 64 + (idx >> 5), pp = idx & 31;
      int fi = pp & 15;
      float inv = exp2f(-(float)fi * (13.287712379549449f / 16.f));
      float pos = (pp < 16) ? (float)(t >> 6) : (float)(t & 63);
      float a = pos * inv;
      rb[t * 32 + pp] = make_float2(cosf(a), sinf(a));
    }
    for (int idx = tid; idx < 64 * 16; idx += 256) {
      int t = j * 64 + (idx >> 4), pp = idx & 15;
      int fi = pp & 7;
      float inv = exp2f(-(float)fi * (13.287712379549449f / 8.f));
      float pos = (pp < 8) ? (float)(t >> 6) : (float)(t & 63);
      float a = pos * inv;
      rd[t * 16 + pp] = make_float2(cosf(a), sinf(a));
    }
  } else if (j == 16) {
    float* lbv = (float*)(p.ws + W_LBV);
    for (int idx = tid; idx < 1024; idx += 256) {
      float a0 = p.lb_logits[idx], a1 = p.lb_logits[1024 + idx];
      lbv[idx] = 0.f;
      lbv[1024 + idx] = sigmoidf_(a1 - a0);
    }
  }
}

DI void cache_job(const Params& p_in, int l, int j, char* smem) {
  Params p = p_in; launder_params(p);
  const int b = j >> 4, p0 = (j & 15) * 32;
  const int tid = tidx();
  const size_t cb = (size_t)(b * 2 + l) * 512 + p0;
  {
    const float* src = p.cgk + cb * 128;
    u16* dst = (u16*)(p.ws + W_KBL) + ((size_t)b * 1536 + p0) * 128;
    for (int idx = tid; idx < 32 * 32; idx += 256) {
      float4 v = ldnt4(src + idx * 4);
      *(uint2*)(dst + idx * 4) = pk4(v.x, v.y, v.z, v.w);
    }
  }
  tr32x128<true>(p.cgv + cb * 128, 128, (u16*)(p.ws + W_VBTL) + (size_t)b * 128 * 1536 + p0, 1536, smem);
  {
    const float* src = p.cnk + cb * 512;
    u16* dst = (u16*)(p.ws + W_NKC) + ((size_t)b * 512 + p0) * 512;
    for (int idx = tid; idx < 32 * 128; idx += 256) {
      float4 v = ldnt4(src + idx * 4);
      *(uint2*)(dst + idx * 4) = pk4(v.x, v.y, v.z, v.w);
    }
  }
  for (int cc = 0; cc < 4; ++cc)
    tr32x128<true>(p.cnv + cb * 512 + cc * 128, 512, (u16*)(p.ws + W_NVTL) + ((size_t)b * 512 + cc * 128) * 1536 + p0, 1536, smem);
  {
    const float* src = p.cckv + cb * 128;
    u16* dst = (u16*)(p.ws + W_ACKV) + ((size_t)8192 + b * 512 + p0) * 128;
    for (int idx = tid; idx < 32 * 32; idx += 256) {
      float4 v = ldnt4(src + idx * 4);
      *(uint2*)(dst + idx * 4) = pk4(v.x, v.y, v.z, v.w);
    }
  }
  {
    const int r = tid >> 3, li = tid & 7;
    float4 v = ldnt4(p.ckr + (cb + r) * 32 + li * 4);
    uint2 o = pk4(v.x, v.y, v.z, v.w);
    u16* dst = (u16*)(p.ws + W_KDL) + ((size_t)b * 1536 + p0 + r) * 768 + 64 + li * 4;
#pragma unroll
    for (int h = 0; h < 8; ++h) *(uint2*)(dst + h * 96) = o;
  }
}

DI void norm_job(const Params& p_in, int l, int which, int job, bool from_input) {
  Params p = p_in; launder_params(p);
  const int tid = tidx(), lane = tid & 63, wave = tid >> 6;
  const int row = job * 4 + wave;
  const float* xs;
  if (from_input) xs = row < NCTX ? p.x_prompt + (size_t)row * D : p.x_sample + (size_t)(row - NCTX) * D;
  else xs = p.out + (size_t)row * D;
  float4 v[4];
  float ss = 0.f;
#pragma unroll
  for (int i = 0; i < 4; ++i) {
    v[i] = from_input ? ldnt4(xs + (i * 64 + lane) * 4) : *(const float4*)(xs + (i * 64 + lane) * 4);
    ss += v[i].x * v[i].x + v[i].y * v[i].y + v[i].z * v[i].z + v[i].w * v[i].w;
  }
#pragma unroll
  for (int o = 32; o >= 1; o >>= 1) ss += shx(ss, o);
  const float rstd = rsqrtf(ss * (1.f / 1024.f) + EPS);
  const int cond = cond_of_row(row);
  const float* mod = (const float*)(p.ws + W_MOD) + (size_t)(l * 5 + cond) * 6144;
  const float* sh = mod + (which ? 3 : 0) * 1024;
  const float* sc = mod + (which ? 4 : 1) * 1024;
  u16* hb = (u16*)(p.ws + W_H) + (size_t)row * D;
#pragma unroll
  for (int i = 0; i < 4; ++i) {
    int c = (i * 64 + lane) * 4;
    float4 a = *(const float4*)(sc + c), s = *(const float4*)(sh + c);
    *(uint2*)(hb + c) = pk4(v[i].x * rstd * (1.f + a.x) + s.x, v[i].y * rstd * (1.f + a.y) + s.y,
                            v[i].z * rstd * (1.f + a.z) + s.z, v[i].w * rstd * (1.f + a.w) + s.w);
    if (from_input) *(float4*)(p.out + (size_t)row * D + c) = v[i];
  }
}

DI void final_norm_job(const Params& p_in, int job) {
  Params p = p_in; launder_params(p);
  const int tid = tidx(), lane = tid & 63, wave = tid >> 6;
  const int row = job * 4 + wave;
  float* xs = p.out + (size_t)row * D;
  float4 v[4];
  float ss = 0.f;
#pragma unroll
  for (int i = 0; i < 4; ++i) {
    v[i] = *(const float4*)(xs + (i * 64 + lane) * 4);
    ss += v[i].x * v[i].x + v[i].y * v[i].y + v[i].z * v[i].z + v[i].w * v[i].w;
  }
#pragma unroll
  for (int o = 32; o >= 1; o >>= 1) ss += shx(ss, o);
  const float rstd = rsqrtf(ss * (1.f / 1024.f) + EPS);
#pragma unroll
  for (int i = 0; i < 4; ++i) {
    int c = (i * 64 + lane) * 4;
    float4 g = *(const float4*)(p.final_gain + c);
    stnt4(xs + c, make_float4(v[i].x * rstd * g.x, v[i].y * rstd * g.y, v[i].z * rstd * g.z, v[i].w * rstd * g.w));
  }
}

DI void prep_job(const Params& p_in, int l, int tile, int part, char* smem) {
  Params p = p_in; launder_params(p);
  const int row0 = tile * 32;
  const bool ctx = row0 < NCTX;
  int b, t0;
  if (ctx) { b = row0 >> 8; t0 = row0 & 255; } else { int rr = row0 - NCTX; b = rr >> 10; t0 = rr & 1023; }
  const u16* pr = (const u16*)(p.ws + W_PROJ) + (size_t)row0 * PW;
  const int tid = tidx(), lane = tid & 63, wave = tid >> 6;
  const float2* ropeB = (const float2*)(p.ws + W_ROPEB);
  const float2* ropeD = (const float2*)(p.ws + W_ROPED);
  const size_t cbase = (size_t)(b * 2 + l) * 256 + t0;

  if (part == 0) {
    const int li = tid & 15;
    const float4 gn = *(const float4*)(p.gq_q_gain + l * 64 + li * 4);
#pragma unroll 8
    for (int pass = 0; pass < 16; ++pass) {
      int vec = pass * 16 + (tid >> 4);
      int r = vec >> 3, h = vec & 7;
      float x[4];
      unpack4(*(const uint2*)(pr + (size_t)r * PW + C_GQ + h * 64 + li * 4), x);
      float ss = x[0] * x[0] + x[1] * x[1] + x[2] * x[2] + x[3] * x[3];
      ss += shx(ss, 1); ss += shx(ss, 2); ss += shx(ss, 4); ss += shx(ss, 8);
      float rstd = rsqrtf(ss * (1.f / 64.f) + EPS);
      float y0 = x[0] * rstd * gn.x, y1 = x[1] * rstd * gn.y, y2 = x[2] * rstd * gn.z, y3 = x[3] * rstd * gn.w;
      if (!ctx) {
        float2 c0 = ropeB[(t0 + r) * 32 + 2 * li], c1 = ropeB[(t0 + r) * 32 + 2 * li + 1];
        float a0 = y0 * c0.x - y1 * c0.y, a1 = y0 * c0.y + y1 * c0.x;
        float a2 = y2 * c1.x - y3 * c1.y, a3 = y2 * c1.y + y3 * c1.x;
        y0 = a0; y1 = a1; y2 = a2; y3 = a3;
      }
      *(uint2*)((u16*)(p.ws + W_QBF) + (size_t)(row0 + r) * 512 + h * 64 + li * 4) = pk4(y0, y1, y2, y3);
    }
  }
  if (part == 0) {
    const int li = tid & 15;
    const float4 gn = *(const float4*)(p.gq_k_gain + l * 64 + li * 4);
#pragma unroll
    for (int pass = 0; pass < 4; ++pass) {
      int vec = pass * 16 + (tid >> 4);
      int r = vec >> 1, kvh = vec & 1;
      float x[4];
      unpack4(*(const uint2*)(pr + (size_t)r * PW + C_GK + kvh * 64 + li * 4), x);
      float ss = x[0] * x[0] + x[1] * x[1] + x[2] * x[2] + x[3] * x[3];
      ss += shx(ss, 1); ss += shx(ss, 2); ss += shx(ss, 4); ss += shx(ss, 8);
      float rstd = rsqrtf(ss * (1.f / 64.f) + EPS);
      float y0 = x[0] * rstd * gn.x, y1 = x[1] * rstd * gn.y, y2 = x[2] * rstd * gn.z, y3 = x[3] * rstd * gn.w;
      if (ctx) {
        stnt4(p.out + O_GQK + (cbase + r) * 128 + kvh * 64 + li * 4, make_float4(y0, y1, y2, y3));
        *(uint2*)((u16*)(p.ws + W_KBC) + (size_t)(row0 + r) * 128 + kvh * 64 + li * 4) = pk4(y0, y1, y2, y3);
      } else {
        float2 c0 = ropeB[(t0 + r) * 32 + 2 * li], c1 = ropeB[(t0 + r) * 32 + 2 * li + 1];
        float a0 = y0 * c0.x - y1 * c0.y, a1 = y0 * c0.y + y1 * c0.x;
        float a2 = y2 * c1.x - y3 * c1.y, a3 = y2 * c1.y + y3 * c1.x;
        *(uint2*)((u16*)(p.ws + W_KBL) + ((size_t)b * 1536 + 512 + t0 + r) * 128 + kvh * 64 + li * 4) = pk4(a0, a1, a2, a3);
      }
    }
  }
  if (part == 1) {
  if (ctx) {
    for (int idx = tid; idx < 32 * 32; idx += 256) {
      int r = idx >> 5, c4 = (idx & 31) * 4;
      float x[4];
      unpack4(*(const uint2*)(pr + (size_t)r * PW + C_GV + c4), x);
      stnt4(p.out + O_GQV + (cbase + r) * 128 + c4, make_float4(x[0], x[1], x[2], x[3]));
    }
    tr32x128<false>(pr + C_GV, PW, (u16*)(p.ws + W_VBTC) + (size_t)b * 128 * 256 + t0, 256, smem);
  } else {
    tr32x128<false>(pr + C_GV, PW, (u16*)(p.ws + W_VBTL) + (size_t)b * 128 * 1536 + 512 + t0, 1536, smem);
  }
  if (ctx) {
    for (int idx = tid; idx < 32 * 128; idx += 256) {
      int r = idx >> 7, c4 = (idx & 127) * 4;
      float x[4];
      unpack4(*(const uint2*)(pr + (size_t)r * PW + C_NK + c4), x);
      stnt4(p.out + O_NAK + (cbase + r) * 512 + c4, make_float4(x[0], x[1], x[2], x[3]));
      unpack4(*(const uint2*)(pr + (size_t)r * PW + C_NV + c4), x);
      stnt4(p.out + O_NAV + (cbase + r) * 512 + c4, make_float4(x[0], x[1], x[2], x[3]));
    }
    for (int cc = 0; cc < 4; ++cc)
      tr32x128<false>(pr + C_NV + cc * 128, PW, (u16*)(p.ws + W_NVTC) + ((size_t)b * 512 + cc * 128) * 256 + t0, 256, smem);
  } else {
    for (int cc = 0; cc < 4; ++cc)
      tr32x128<false>(pr + C_NV + cc * 128, PW, (u16*)(p.ws + W_NVTL) + ((size_t)b * 512 + cc * 128) * 1536 + 512 + t0, 1536, smem);
  }
  }
  if (part == 0) {
    const float4 gn = *(const float4*)(p.ml_q_a_gain + l * 256 + lane * 4);
#pragma unroll
    for (int pass = 0; pass < 8; ++pass) {
      int r = pass * 4 + wave;
      float x[4];
      unpack4(*(const uint2*)(pr + (size_t)r * PW + C_MQA + lane * 4), x);
      float ss = x[0] * x[0] + x[1] * x[1] + x[2] * x[2] + x[3] * x[3];
#pragma unroll
      for (int o = 32; o >= 1; o >>= 1) ss += shx(ss, o);
      float rstd = rsqrtf(ss * (1.f / 256.f) + EPS);
      *(uint2*)((u16*)(p.ws + W_AQ) + (size_t)(row0 + r) * 256 + lane * 4) =
          pk4(x[0] * rstd * gn.x, x[1] * rstd * gn.y, x[2] * rstd * gn.z, x[3] * rstd * gn.w);
    }
  }
  if (part == 0) {
    const int li = tid & 31;
    const float4 gn = *(const float4*)(p.ml_kv_a_gain + l * 128 + li * 4);
#pragma unroll
    for (int pass = 0; pass < 4; ++pass) {
      int r = pass * 8 + (tid >> 5);
      float x[4];
      unpack4(*(const uint2*)(pr + (size_t)r * PW + C_MKVA + li * 4), x);
      float ss = x[0] * x[0] + x[1] * x[1] + x[2] * x[2] + x[3] * x[3];
#pragma unroll
      for (int o = 16; o >= 1; o >>= 1) ss += shx(ss, o);
      float rstd = rsqrtf(ss * (1.f / 128.f) + EPS);
      float y0 = x[0] * rstd * gn.x, y1 = x[1] * rstd * gn.y, y2 = x[2] * rstd * gn.z, y3 = x[3] * rstd * gn.w;
      *(uint2*)((u16*)(p.ws + W_ACKV) + (size_t)(row0 + r) * 128 + li * 4) = pk4(y0, y1, y2, y3);
      if (ctx) stnt4(p.out + O_CKV + (cbase + r) * 128 + li * 4, make_float4(y0, y1, y2, y3));
    }
  }
  if (part == 0) {
    const int r = tid >> 3, li = tid & 7;
    float x[4];
    unpack4(*(const uint2*)(pr + (size_t)r * PW + C_MKR + li * 4), x);
    if (ctx) {
      stnt4(p.out + O_KR + (cbase + r) * 32 + li * 4, make_float4(x[0], x[1], x[2], x[3]));
      uint2 o = pk4(x[0], x[1], x[2], x[3]);
      u16* dst = (u16*)(p.ws + W_KDC) + (size_t)(row0 + r) * 768 + 64 + li * 4;
#pragma unroll
      for (int h = 0; h < 8; ++h) *(uint2*)(dst + h * 96) = o;
    } else {
      float2 c0 = ropeD[(t0 + r) * 16 + 2 * li], c1 = ropeD[(t0 + r) * 16 + 2 * li + 1];
      float a0 = x[0] * c0.x - x[1] * c0.y, a1 = x[0] * c0.y + x[1] * c0.x;
      float a2 = x[2] * c1.x - x[3] * c1.y, a3 = x[2] * c1.y + x[3] * c1.x;
      uint2 o = pk4(a0, a1, a2, a3);
      u16* dst = (u16*)(p.ws + W_KDL) + ((size_t)b * 1536 + 512 + t0 + r) * 768 + 64 + li * 4;
#pragma unroll
      for (int h = 0; h < 8; ++h) *(uint2*)(dst + h * 96) = o;
    }
  }
}

struct AttnP {
  const u16* q; size_t qs;
  const u16* k; size_t ks;
  const u16* vt; size_t vs;
  int ntiles;
  float sscale;
  u16* o; size_t os;
  const float2* rope; int tq;
  const u16* k2; size_t ks2;
  int grow, c0;
  int krlo;
  const float* rpbs;
};

template <int DK, int MODE>
DI void attn_block(const AttnP& a, char* smem) {
  constexpr int NS = DK / 16;
  constexpr int KROW = DK * 2 + 16;
  constexpr int VROW = 144;
  constexpr int KCH = DK / 8;
  constexpr int KPT = KCH * 64 / 256;
  char* Ks = smem;
  char* Vs = smem + 2 * 64 * KROW;
  const int tid = tidx(), lane = tid & 63, r = lane & 31, g = lane >> 5;
  bf16x8 qf[NS];
#pragma unroll
  for (int s = 0; s < NS; ++s) qf[s] = *(const bf16x8*)(a.q + (size_t)r * a.qs + 16 * s + 8 * g);
  if (MODE == 1) {
#pragma unroll
    for (int s = 4; s < 6; ++s) {
      uint4 u = __builtin_bit_cast(uint4, qf[s]);
      float x[8];
      unpack8(u, x);
      const float2* rp = a.rope + (size_t)(a.tq + r) * 16 + (s - 4) * 8 + 4 * g;
      float y[8];
#pragma unroll
      for (int pp = 0; pp < 4; ++pp) {
        float2 cs = rp[pp];
        y[2 * pp] = x[2 * pp] * cs.x - x[2 * pp + 1] * cs.y;
        y[2 * pp + 1] = x[2 * pp] * cs.y + x[2 * pp + 1] * cs.x;
      }
      uint4 o;
      o.x = pk2(y[0], y[1]); o.y = pk2(y[2], y[3]); o.z = pk2(y[4], y[5]); o.w = pk2(y[6], y[7]);
      qf[s] = __builtin_bit_cast(bf16x8, o);
    }
  }
  f32x16 oacc[2];
#pragma unroll
  for (int i = 0; i < 16; ++i) { oacc[0][i] = 0.f; oacc[1][i] = 0.f; }
  float m = -1e30f, lsum = 0.f;
  int kr0 = 0, qc = 0, cs0 = 0;
  if (MODE == 2) {
    kr0 = a.grow - 4; kr0 = kr0 < 0 ? 0 : (kr0 > 8 ? 8 : kr0);
    qc = a.c0 + r;
    cs0 = qc - 8; cs0 = cs0 < 0 ? 0 : (cs0 > 48 ? 48 : cs0);
  }
  u32x4 rk[KPT], rv[2];
  int krow_i[KPT], kkc[KPT];
#pragma unroll
  for (int i = 0; i < KPT; ++i) { int c = tid + 256 * i; krow_i[i] = c / KCH; kkc[i] = c % KCH; }
  const int vrow_i = tid >> 3, vkc = tid & 7;
#define ATT_GLOAD(KT)                                                                                   \
  {                                                                                                     \
    const u16* kb_;                                                                                     \
    size_t kst_;                                                                                        \
    int vkey_;                                                                                          \
    if (MODE == 2 && (KT) >= 8) {                                                                       \
      int tok_ = (a.krlo + (KT) - 8) * 64;                                                              \
      kb_ = a.k2 + (size_t)tok_ * a.ks2; kst_ = a.ks2; vkey_ = 512 + tok_;                              \
    } else {                                                                                            \
      kb_ = a.k + (size_t)((KT) * 64) * a.ks; kst_ = a.ks; vkey_ = (KT) * 64;                           \
    }                                                                                                   \
    _Pragma("unroll") for (int i = 0; i < KPT; ++i)                                                     \
      rk[i] = *(const u32x4*)(kb_ + (size_t)krow_i[i] * kst_ + kkc[i] * 8);                             \
    rv[0] = *(const u32x4*)(a.vt + (size_t)vrow_i * a.vs + vkey_ + vkc * 8);                            \
    rv[1] = *(const u32x4*)(a.vt + (size_t)(vrow_i + 32) * a.vs + vkey_ + vkc * 8);                     \
  }
#define ATT_SSTORE(BUF)                                                                                 \
  {                                                                                                     \
    _Pragma("unroll") for (int i = 0; i < KPT; ++i)                                                     \
      *(u32x4*)(Ks + ((BUF) * 64 + krow_i[i]) * KROW + kkc[i] * 16) = rk[i];                            \
    *(u32x4*)(Vs + ((BUF) * 64 + vrow_i) * VROW + vkc * 16) = rv[0];                                    \
    *(u32x4*)(Vs + ((BUF) * 64 + vrow_i + 32) * VROW + vkc * 16) = rv[1];                               \
  }
  ATT_GLOAD(0)
  ATT_SSTORE(0)
  __syncthreads();
  for (int kt = 0; kt < a.ntiles; ++kt) {
    const int buf = kt & 1;
    const int ktn = (kt + 1 < a.ntiles) ? kt + 1 : kt;
    ATT_GLOAD(ktn)
    __builtin_amdgcn_sched_barrier(0);
    float sv[2][16];
#pragma unroll
    for (int u = 0; u < 2; ++u) {
      f32x16 sacc;
#pragma unroll
      for (int i = 0; i < 16; ++i) sacc[i] = 0.f;
      const char* kp = Ks + (buf * 64 + u * 32 + r) * KROW + g * 16;
#pragma unroll
      for (int s = 0; s < NS; ++s) sacc = MFMA32(*(const bf16x8*)(kp + s * 32), qf[s], sacc);
#pragma unroll
      for (int i = 0; i < 16; ++i) sv[u][i] = sacc[i];
    }
    float mn;
    if (MODE == 2 && kt >= 8) {
      const int krow_ = a.krlo + kt - 8;
      const bool rowok = (krow_ >= kr0) && (krow_ < kr0 + 8);
      int dr = krow_ - a.grow + 7;
      dr = dr < 0 ? 0 : (dr > 14 ? 14 : dr);
#pragma unroll
      for (int u = 0; u < 2; ++u)
#pragma unroll
        for (int i = 0; i < 16; ++i) {
          int kc = u * 32 + crow(i, g);
          bool ok = rowok && (kc >= cs0) && (kc < cs0 + 16);
          int dc = kc - qc + 15; dc = dc < 0 ? 0 : (dc > 30 ? 30 : dc);
          sv[u][i] = ok ? fmaf(sv[u][i], a.sscale, a.rpbs[dr * 31 + dc]) : -INFINITY;
        }
      float mx = sv[0][0];
#pragma unroll
      for (int u = 0; u < 2; ++u)
#pragma unroll
        for (int i = 0; i < 16; ++i) mx = fmaxf(mx, sv[u][i]);
      mx = fmaxf(mx, shx(mx, 32));
      mn = fmaxf(m, mx);
#pragma unroll
      for (int u = 0; u < 2; ++u)
#pragma unroll
        for (int i = 0; i < 16; ++i) sv[u][i] = __builtin_amdgcn_exp2f(sv[u][i] - mn);
    } else {
      float mx = sv[0][0];
#pragma unroll
      for (int u = 0; u < 2; ++u)
#pragma unroll
        for (int i = 0; i < 16; ++i) mx = fmaxf(mx, sv[u][i]);
      mx = fmaxf(mx, shx(mx, 32)) * a.sscale;
      mn = fmaxf(m, mx);
#pragma unroll
      for (int u = 0; u < 2; ++u)
#pragma unroll
        for (int i = 0; i < 16; ++i) sv[u][i] = __builtin_amdgcn_exp2f(fmaf(sv[u][i], a.sscale, -mn));
    }
    float ps = 0.f;
#pragma unroll
    for (int u = 0; u < 2; ++u)
#pragma unroll
      for (int i = 0; i < 16; ++i) ps += sv[u][i];
    if (__any(mn > m)) {
      const float alpha = __builtin_amdgcn_exp2f(m - mn);
      lsum *= alpha;
#pragma unroll
      for (int i = 0; i < 16; ++i) { oacc[0][i] *= alpha; oacc[1][i] *= alpha; }
      m = mn;
    }
    lsum += ps;
    ATT_SSTORE(buf ^ 1)
#pragma unroll
    for (int u = 0; u < 2; ++u)
#pragma unroll
      for (int s2 = 0; s2 < 2; ++s2) {
        uint4 pu;
        pu.x = pk2(sv[u][8 * s2 + 0], sv[u][8 * s2 + 1]); pu.y = pk2(sv[u][8 * s2 + 2], sv[u][8 * s2 + 3]);
        pu.z = pk2(sv[u][8 * s2 + 4], sv[u][8 * s2 + 5]); pu.w = pk2(sv[u][8 * s2 + 6], sv[u][8 * s2 + 7]);
        const bf16x8 pf = __builtin_bit_cast(bf16x8, pu);
#pragma unroll
        for (int mb = 0; mb < 2; ++mb) {
          const char* vp = Vs + (buf * 64 + mb * 32 + r) * VROW + (u * 32 + 16 * s2 + 4 * g) * 2;
          bf16x4 lo = *(const bf16x4*)(vp);
          bf16x4 hi = *(const bf16x4*)(vp + 16);
          oacc[mb] = MFMA32(__builtin_shufflevector(lo, hi, 0, 1, 2, 3, 4, 5, 6, 7), pf, oacc[mb]);
        }
      }
    __syncthreads();
  }
#undef ATT_GLOAD
#undef ATT_SSTORE
  lsum += shx(lsum, 32);
  const float inv = frcp(lsum);
#pragma unroll
  for (int mb = 0; mb < 2; ++mb)
#pragma unroll
    for (int q4 = 0; q4 < 4; ++q4) {
      int dv = mb * 32 + 8 * q4 + 4 * g;
      *(uint2*)(a.o + (size_t)r * a.os + dv) = pk4(oacc[mb][4 * q4 + 0] * inv, oacc[mb][4 * q4 + 1] * inv,
                                                    oacc[mb][4 * q4 + 2] * inv, oacc[mb][4 * q4 + 3] * inv);
    }
}

DI void gqa_item(const Params& p_in, int lat, int item, char* smem) {
  Params p = p_in; launder_params(p);
  const int wave = tidx() >> 6;
  AttnP a;
  a.sscale = 0.125f * LOG2E;
  a.rope = nullptr; a.tq = 0; a.k2 = nullptr; a.ks2 = 0; a.grow = 0; a.c0 = 0; a.rpbs = nullptr; a.krlo = 0;
  if (lat) {
    int b = item >> 6, h = (item >> 3) & 7, qt = item & 7;
    int row = NCTX + b * 1024 + qt * 128 + wave * 32;
    a.q = (const u16*)(p.ws + W_QBF) + (size_t)row * 512 + h * 64; a.qs = 512;
    a.k = (const u16*)(p.ws + W_KBL) + (size_t)b * 1536 * 128 + (h >> 2) * 64; a.ks = 128;
    a.vt = (const u16*)(p.ws + W_VBTL) + ((size_t)b * 128 + (h >> 2) * 64) * 1536; a.vs = 1536;
    a.ntiles = 24;
    a.o = (u16*)(p.ws + W_BRANCH) + (size_t)row * 2048 + 512 + h * 64; a.os = 2048;
  } else {
    int b = item >> 4, h = (item >> 1) & 7, qt = item & 1;
    int row = b * 256 + qt * 128 + wave * 32;
    a.q = (const u16*)(p.ws + W_QBF) + (size_t)row * 512 + h * 64; a.qs = 512;
    a.k = (const u16*)(p.ws + W_KBC) + (size_t)b * 256 * 128 + (h >> 2) * 64; a.ks = 128;
    a.vt = (const u16*)(p.ws + W_VBTC) + ((size_t)b * 128 + (h >> 2) * 64) * 256; a.vs = 256;
    a.ntiles = 4;
    a.o = (u16*)(p.ws + W_BRANCH) + (size_t)row * 2048 + 512 + h * 64; a.os = 2048;
  }
  attn_block<64, 0>(a, smem);
}

DI void na_ctx_item(const Params& p_in, int item, char* smem) {
  Params p = p_in; launder_params(p);
  const int wave = tidx() >> 6;
  AttnP a;
  a.sscale = 0.125f * LOG2E;
  a.rope = nullptr; a.tq = 0; a.k2 = nullptr; a.ks2 = 0; a.grow = 0; a.c0 = 0; a.rpbs = nullptr; a.krlo = 0;
  int b = item >> 4, h = (item >> 1) & 7, qt = item & 1;
  int row = b * 256 + qt * 128 + wave * 32;
  const u16* pr = (const u16*)(p.ws + W_PROJ);
  a.q = pr + (size_t)row * PW + C_NQ + h * 64; a.qs = PW;
  a.k = pr + (size_t)(b * 256) * PW + C_NK + h * 64; a.ks = PW;
  a.vt = (const u16*)(p.ws + W_NVTC) + ((size_t)b * 512 + h * 64) * 256; a.vs = 256;
  a.ntiles = 4;
  a.o = (u16*)(p.ws + W_BRANCH) + (size_t)row * 2048 + 1024 + h * 64; a.os = 2048;
  attn_block<64, 0>(a, smem);
}

DI void na_lat_item(const Params& p_in, int l, int item, char* smem) {
  Params p = p_in; launder_params(p);
  const int tid = tidx(), wave = tid >> 6;
  int b = item >> 6, h = (item >> 3) & 7, rp = item & 7;
  float* rpbs = (float*)(smem + 65536);
  for (int idx = tid; idx < 15 * 31; idx += 256) rpbs[idx] = p.na_rpb[(size_t)(l * 8 + h) * 465 + idx] * LOG2E;
  __syncthreads();
  AttnP a;
  a.sscale = 0.125f * LOG2E;
  a.rope = nullptr; a.tq = 0;
  const int grow = rp * 2 + (wave >> 1), c0 = (wave & 1) * 32;
  int row = NCTX + b * 1024 + grow * 64 + c0;
  const u16* pr = (const u16*)(p.ws + W_PROJ);
  a.q = pr + (size_t)row * PW + C_NQ + h * 64; a.qs = PW;
  a.k = (const u16*)(p.ws + W_NKC) + (size_t)b * 512 * 512 + h * 64; a.ks = 512;
  a.vt = (const u16*)(p.ws + W_NVTL) + ((size_t)b * 512 + h * 64) * 1536; a.vs = 1536;
  a.k2 = pr + (size_t)(NCTX + b * 1024) * PW + C_NK + h * 64; a.ks2 = PW;
  a.grow = grow; a.c0 = c0; a.rpbs = rpbs;
  int lo = rp * 2 - 4; lo = lo < 0 ? 0 : (lo > 8 ? 8 : lo);
  int hi = rp * 2 + 1 - 4; hi = hi < 0 ? 0 : (hi > 8 ? 8 : hi);
  a.krlo = lo;
  a.ntiles = 8 + (hi + 8 - lo);
  a.o = (u16*)(p.ws + W_BRANCH) + (size_t)row * 2048 + 1024 + h * 64; a.os = 2048;
  attn_block<64, 2>(a, smem);
}

DI void mla_item(const Params& p_in, int lat, int item, char* smem) {
  Params p = p_in; launder_params(p);
  const int wave = tidx() >> 6;
  AttnP a;
  a.sscale = 0.10206207261596577f * LOG2E;
  a.rope = (const float2*)(p.ws + W_ROPED); a.tq = 0; a.k2 = nullptr; a.ks2 = 0; a.grow = 0; a.c0 = 0; a.rpbs = nullptr; a.krlo = 0;
  if (lat) {
    int b = item >> 6, h = (item >> 3) & 7, qt = item & 7;
    int t = qt * 128 + wave * 32;
    int row = NCTX + b * 1024 + t;
    a.tq = t;
    a.q = (const u16*)(p.ws + W_QD) + (size_t)row * 768 + h * 96; a.qs = 768;
    a.k = (const u16*)(p.ws + W_KDL) + (size_t)b * 1536 * 768 + h * 96; a.ks = 768;
    a.vt = (const u16*)(p.ws + W_VDTL) + ((size_t)b * 512 + h * 64) * 1536; a.vs = 1536;
    a.ntiles = 24;
    a.o = (u16*)(p.ws + W_BRANCH) + (size_t)row * 2048 + 1536 + h * 64; a.os = 2048;
    attn_block<96, 1>(a, smem);
  } else {
    int b = item >> 4, h = (item >> 1) & 7, qt = item & 1;
    int row = b * 256 + qt * 128 + wave * 32;
    a.q = (const u16*)(p.ws + W_QD) + (size_t)row * 768 + h * 96; a.qs = 768;
    a.k = (const u16*)(p.ws + W_KDC) + (size_t)(b * 256) * 768 + h * 96; a.ks = 768;
    a.vt = (const u16*)(p.ws + W_VDTC) + ((size_t)b * 512 + h * 64) * 256; a.vs = 256;
    a.ntiles = 4;
    a.o = (u16*)(p.ws + W_BRANCH) + (size_t)row * 2048 + 1536 + h * 64; a.os = 2048;
    attn_block<96, 0>(a, smem);
  }
}

DI void hgrn_item(const Params& p_in, int l, int lat, int item, char* smem) {
  Params p = p_in; launder_params(p);
  const int tid = tidx();
  const int seq = item >> 3, vsl = item & 7;
  const int dir = seq & 1, h = (seq >> 1) & 3, b = seq >> 3;
  const int T = lat ? 1024 : 256;
  const int rowbase = lat ? NCTX + b * 1024 : b * 256;
  const int vi = tid & 15, kg = tid >> 4;
  float* qs = (float*)smem;
  float* fs = qs + 2 * 16 * 128;
  float* vsm = fs + 2 * 16 * 128;
  float* red = vsm + 2 * 16 * 16;
  f32x2 S2[4];
  if (lat) {
    const float* sp = p.state_hgrn + ((((size_t)(b * 2 + l) * 2 + dir) * 4 + h) * 128 + kg * 8) * 128 + vsl * 16 + vi;
#pragma unroll
    for (int kk = 0; kk < 4; ++kk) { S2[kk][0] = sp[(2 * kk) * 128]; S2[kk][1] = sp[(2 * kk + 1) * 128]; }
  } else {
#pragma unroll
    for (int kk = 0; kk < 4; ++kk) { S2[kk][0] = 0.f; S2[kk][1] = 0.f; }
  }
  const u16* pr = (const u16*)(p.ws + W_PROJ);
  const int ltok = tid >> 4, lk8 = (tid & 15) * 8;
  float lb[8];
  {
    const float* lp = (const float*)(p.ws + W_LBV) + (l * 2 + dir) * 512 + h * 128 + lk8;
#pragma unroll
    for (int i = 0; i < 8; ++i) lb[i] = lp[i];
  }
  const int fcol = (dir ? C_HFB : C_HFF) + h * 128 + lk8;
  const int qcol = C_HQ + h * 128 + lk8;
  const int vcol = C_HI + h * 128 + vsl * 16 + vi;
  const int nchunk = T >> 4;
  uint4 rq, rf;
  u16 rv;
  auto tokidx = [&](int c, int j) { int s = c * 16 + j; return dir ? (T - 1 - s) : s; };
  auto gload = [&](int c) {
    size_t ro = (size_t)(rowbase + tokidx(c, ltok)) * PW;
    rq = *(const uint4*)(pr + ro + qcol);
    rf = *(const uint4*)(pr + ro + fcol);
    rv = pr[ro + vcol];
  };
  auto sstore = [&](int buf) {
    float q8[8], f8[8];
    unpack8(rq, q8);
    unpack8(rf, f8);
    float* qd = qs + (buf * 16 + ltok) * 128 + lk8;
    float* fd = fs + (buf * 16 + ltok) * 128 + lk8;
#pragma unroll
    for (int i = 0; i < 8; ++i) {
      qd[i] = q8[i] * 0.08838834764831845f;
      fd[i] = lb[i] + (1.f - lb[i]) * sigmoidf_(f8[i]);
    }
    vsm[(buf * 16 + ltok) * 16 + vi] = bf2f(rv);
  };
  gload(0);
  sstore(0);
  __syncthreads();
  u16* obase = dir ? (u16*)(p.ws + W_OB) : (u16*)(p.ws + W_BRANCH);
  const size_t ostride = dir ? 512 : 2048;
#define HG_LD(J, FA, FB, QA, QB, VV)                                    \
  {                                                                     \
    const float* fp_ = fs + (buf * 16 + (J)) * 128 + kg * 8;            \
    const float* qp_ = qs + (buf * 16 + (J)) * 128 + kg * 8;            \
    FA = *(const float4*)(fp_); FB = *(const float4*)(fp_ + 4);         \
    QA = *(const float4*)(qp_); QB = *(const float4*)(qp_ + 4);         \
    VV = vsm[(buf * 16 + (J)) * 16 + vi];                               \
  }
#define HG_STEP(J, FA, FB, QA, QB, VV)                                  \
  {                                                                     \
    const f32x2 v2 = {VV, VV};                                          \
    const f32x2 f0 = {FA.x, FA.y}, f1 = {FA.z, FA.w}, f2 = {FB.x, FB.y}, f3 = {FB.z, FB.w}; \
    const f32x2 q0 = {QA.x, QA.y}, q1 = {QA.z, QA.w}, q2 = {QB.x, QB.y}, q3 = {QB.z, QB.w}; \
    S2[0] = f0 * (S2[0] - v2) + v2;                                     \
    S2[1] = f1 * (S2[1] - v2) + v2;                                     \
    S2[2] = f2 * (S2[2] - v2) + v2;                                     \
    S2[3] = f3 * (S2[3] - v2) + v2;                                     \
    f32x2 op2 = S2[0] * q0;                                             \
    op2 = S2[1] * q1 + op2;                                             \
    op2 = S2[2] * q2 + op2;                                             \
    op2 = S2[3] * q3 + op2;                                             \
    red[((J) * 16 + kg) * 16 + vi] = op2[0] + op2[1];                   \
  }
  for (int c = 0; c < nchunk; ++c) {
    const int buf = c & 1;
    const int cn = (c + 1 < nchunk) ? c + 1 : c;
    gload(cn);
    __builtin_amdgcn_sched_barrier(0);
    float4 fa[2][4], fb[2][4], qa[2][4], qb[2][4];
    float vv[2][4];
#pragma unroll
    for (int t = 0; t < 4; ++t) HG_LD(t, fa[0][t], fb[0][t], qa[0][t], qb[0][t], vv[0][t])
#pragma unroll
    for (int jb = 0; jb < 4; ++jb) {
      if (jb < 3) {
#pragma unroll
        for (int t = 0; t < 4; ++t)
          HG_LD(jb * 4 + 4 + t, fa[(jb + 1) & 1][t], fb[(jb + 1) & 1][t], qa[(jb + 1) & 1][t], qb[(jb + 1) & 1][t], vv[(jb + 1) & 1][t])
      }
      __builtin_amdgcn_sched_barrier(0);
#pragma unroll
      for (int t = 0; t < 4; ++t) HG_STEP(jb * 4 + t, fa[jb & 1][t], fb[jb & 1][t], qa[jb & 1][t], qb[jb & 1][t], vv[jb & 1][t])
      __builtin_amdgcn_sched_barrier(0);
    }
    __syncthreads();
    {
      float o = 0.f;
#pragma unroll
      for (int k2 = 0; k2 < 16; ++k2) o += red[(ltok * 16 + k2) * 16 + vi];
      obase[(size_t)(rowbase + tokidx(c, ltok)) * ostride + h * 128 + vsl * 16 + vi] = f2bf(o);
    }
    sstore(buf ^ 1);
    __syncthreads();
  }
#undef HG_LD
#undef HG_STEP
  if (!lat) {
    float* sp = p.out + O_STATE + ((((size_t)(b * 2 + l) * 2 + dir) * 4 + h) * 128 + kg * 8) * 128 + vsl * 16 + vi;
#pragma unroll
    for (int kk = 0; kk < 4; ++kk) { sp[(2 * kk) * 128] = S2[kk][0]; sp[(2 * kk + 1) * 128] = S2[kk][1]; }
  }
}

DI void hgrn_mfma_item(const Params& p_in, int l, int lat, int seq, char* smem) {
  Params p = p_in; launder_params(p);
  const int tid = tidx(), lane = tid & 63, wave = tid >> 6, r = lane & 31, g = lane >> 5;
  const int dir = seq & 1, h = (seq >> 1) & 3, b = seq >> 3;
  const int T = lat ? 1024 : 256;
  const int rowbase = lat ? NCTX + b * 1024 : b * 256;
  constexpr int QROW = 272, EROW = 80;
  char* QT = smem;
  char* KT = QT + 32 * QROW;
  char* KE = KT + 32 * QROW;
  char* VT = KE + 128 * EROW;
  float* EMID = (float*)(VT + 128 * EROW);
  float* DEC = EMID + 128;
  float* TOT = DEC + 128;
  const int kk = tid & 127, hf = tid >> 7;
  f32x16 S[4];
  if (lat) {
    const float* sp = p.state_hgrn + (((size_t)(b * 2 + l) * 2 + dir) * 4 + h) * 16384 + wave * 32 + r;
#pragma unroll
    for (int kb = 0; kb < 4; ++kb)
#pragma unroll
      for (int i = 0; i < 16; ++i) S[kb][i] = sp[(size_t)(kb * 32 + crow(i, g)) * 128];
  } else {
#pragma unroll
    for (int kb = 0; kb < 4; ++kb)
#pragma unroll
      for (int i = 0; i < 16; ++i) S[kb][i] = 0.f;
  }
  const u16* pr = (const u16*)(p.ws + W_PROJ);
  const float lbk = ((const float*)(p.ws + W_LBV))[(l * 2 + dir) * 512 + h * 128 + kk];
  const int fcol = (dir ? C_HFB : C_HFF) + h * 128 + kk;
  const int qcol = C_HQ + h * 128 + kk;
  const int vcol = C_HI + h * 128 + kk;
  const int nchunk = T >> 5;
  u16 rf[16], rq[16], rv[16];
#define HG_GLOAD(C)                                                                  \
  {                                                                                  \
    _Pragma("unroll") for (int i = 0; i < 16; ++i) {                                 \
      int sp_ = (C) * 32 + hf * 16 + i;                                              \
      int tok_ = dir ? (T - 1 - sp_) : sp_;                                          \
      const u16* rp_ = pr + (size_t)(rowbase + tok_) * PW;                           \
      rf[i] = rp_[fcol]; rq[i] = rp_[qcol]; rv[i] = rp_[vcol];                       \
    }                                                                                \
  }
  u16* obase = dir ? (u16*)(p.ws + W_OB) : (u16*)(p.ws + W_BRANCH);
  const size_t ostride = dir ? 512 : 2048;
  HG_GLOAD(0)
  for (int c = 0; c < nchunk; ++c) {
    float kv[16], ef[16], qv[16];
    unsigned vp[8];
    float run = 1.f;
#pragma unroll
    for (int i = 0; i < 16; ++i) {
      qv[i] = bf2f(rq[i]) * 0.08838834764831845f;
      if (i & 1) vp[i >> 1] |= ((unsigned)rv[i]) << 16; else vp[i >> 1] = (unsigned)rv[i];
    }
    if (hf) {
#pragma unroll
      for (int i = 0; i < 16; ++i) {
        const float f = lbk + (1.f - lbk) * sigmoidf_(bf2f(rf[i]));
        kv[i] = 1.f - f;
        run *= f; ef[i] = run;
      }
    } else {
#pragma unroll
      for (int i = 15; i >= 0; --i) {
        const float f = lbk + (1.f - lbk) * sigmoidf_(bf2f(rf[i]));
        kv[i] = 1.f - f;
        ef[i] = run; run *= f;
      }
    }
    TOT[hf * 128 + kk] = run;
    {
      const int cn = (c + 1 < nchunk) ? c + 1 : c;
      HG_GLOAD(cn)
    }
    __builtin_amdgcn_sched_barrier(0);
    __syncthreads();
    {
      const float F0 = TOT[kk], F1 = TOT[128 + kk];
      unsigned ke[8];
#pragma unroll
      for (int i = 0; i < 16; ++i) {
        const int tl = hf * 16 + i;
        const float inv = frcp(ef[i]);
        const float eq = hf ? ef[i] : inv;
        const float ek = hf ? inv : ef[i];
        const float ee = ek * F1;
        *(u16*)(QT + tl * QROW + kk * 2) = f2bf(qv[i] * eq);
        *(u16*)(KT + tl * QROW + kk * 2) = f2bf(kv[i] * ek);
        const float ken = kv[i] * ee;
        if (i & 1) ke[i >> 1] = pk2(__uint_as_float(ke[i >> 1]), ken);
        else ke[i >> 1] = __float_as_uint(ken);
      }
      *(uint4*)(KE + kk * EROW + hf * 32) = make_uint4(ke[0], ke[1], ke[2], ke[3]);
      *(uint4*)(KE + kk * EROW + hf * 32 + 16) = make_uint4(ke[4], ke[5], ke[6], ke[7]);
      *(uint4*)(VT + kk * EROW + hf * 32) = make_uint4(vp[0], vp[1], vp[2], vp[3]);
      *(uint4*)(VT + kk * EROW + hf * 32 + 16) = make_uint4(vp[4], vp[5], vp[6], vp[7]);
      if (hf == 0) { EMID[kk] = F0; DEC[kk] = F0 * F1; }
    }
    __syncthreads();
    f32x16 oacc;
#pragma unroll
    for (int i = 0; i < 16; ++i) oacc[i] = 0.f;
#pragma unroll
    for (int kb = 0; kb < 4; ++kb) {
#pragma unroll
      for (int s = 0; s < 2; ++s) {
        const float4 e0 = *(const float4*)(EMID + kb * 32 + 16 * s + 4 * g);
        const float4 e1 = *(const float4*)(EMID + kb * 32 + 16 * s + 8 + 4 * g);
        uint4 au;
        au.x = pk2(S[kb][8 * s + 0] * e0.x, S[kb][8 * s + 1] * e0.y);
        au.y = pk2(S[kb][8 * s + 2] * e0.z, S[kb][8 * s + 3] * e0.w);
        au.z = pk2(S[kb][8 * s + 4] * e1.x, S[kb][8 * s + 5] * e1.y);
        au.w = pk2(S[kb][8 * s + 6] * e1.z, S[kb][8 * s + 7] * e1.w);
        const char* qp = QT + r * QROW + (kb * 32 + 16 * s + 4 * g) * 2;
        bf16x4 lo = *(const bf16x4*)(qp);
        bf16x4 hi = *(const bf16x4*)(qp + 16);
        oacc = MFMA32(__builtin_bit_cast(bf16x8, au), __builtin_shufflevector(lo, hi, 0, 1, 2, 3, 4, 5, 6, 7), oacc);
      }
    }
    f32x16 sacc;
#pragma unroll
    for (int i = 0; i < 16; ++i) sacc[i] = 0.f;
#pragma unroll
    for (int ks = 0; ks < 8; ++ks) {
      bf16x8 ka = *(const bf16x8*)(KT + r * QROW + (16 * ks + 8 * g) * 2);
      bf16x8 qb = *(const bf16x8*)(QT + r * QROW + (16 * ks + 8 * g) * 2);
      sacc = MFMA32(ka, qb, sacc);
    }
#pragma unroll
    for (int i = 0; i < 16; ++i) sacc[i] = (crow(i, g) <= r) ? sacc[i] : 0.f;
#pragma unroll
    for (int s2 = 0; s2 < 2; ++s2) {
      uint4 pu;
      pu.x = pk2(sacc[8 * s2 + 0], sacc[8 * s2 + 1]); pu.y = pk2(sacc[8 * s2 + 2], sacc[8 * s2 + 3]);
      pu.z = pk2(sacc[8 * s2 + 4], sacc[8 * s2 + 5]); pu.w = pk2(sacc[8 * s2 + 6], sacc[8 * s2 + 7]);
      const char* vq = VT + (wave * 32 + r) * EROW + (16 * s2 + 4 * g) * 2;
      bf16x4 lo = *(const bf16x4*)(vq);
      bf16x4 hi = *(const bf16x4*)(vq + 16);
      oacc = MFMA32(__builtin_shufflevector(lo, hi, 0, 1, 2, 3, 4, 5, 6, 7), __builtin_bit_cast(bf16x8, pu), oacc);
    }
    {
      int sp_ = c * 32 + r;
      int tok_ = dir ? (T - 1 - sp_) : sp_;
      u16* op = obase + (size_t)(rowbase + tok_) * ostride + h * 128 + wave * 32 + 4 * g;
#pragma unroll
      for (int q4 = 0; q4 < 4; ++q4)
        *(uint2*)(op + 8 * q4) = pk4(oacc[4 * q4 + 0], oacc[4 * q4 + 1], oacc[4 * q4 + 2], oacc[4 * q4 + 3]);
    }
#pragma unroll
    for (int kb = 0; kb < 4; ++kb) {
#pragma unroll
      for (int q4 = 0; q4 < 4; ++q4) {
        const float4 d4 = *(const float4*)(DEC + kb * 32 + 8 * q4 + 4 * g);
        S[kb][4 * q4 + 0] *= d4.x; S[kb][4 * q4 + 1] *= d4.y; S[kb][4 * q4 + 2] *= d4.z; S[kb][4 * q4 + 3] *= d4.w;
      }
#pragma unroll
      for (int s = 0; s < 2; ++s) {
        bf16x8 ka = *(const bf16x8*)(KE + (kb * 32 + r) * EROW + (16 * s + 8 * g) * 2);
        bf16x8 vb = *(const bf16x8*)(VT + (wave * 32 + r) * EROW + (16 * s + 8 * g) * 2);
        S[kb] = MFMA32(ka, vb, S[kb]);
      }
    }
    __syncthreads();
  }
#undef HG_GLOAD
  if (!lat) {
    float* sp = p.out + O_STATE + (((size_t)(b * 2 + l) * 2 + dir) * 4 + h) * 16384 + wave * 32 + r;
#pragma unroll
    for (int kb = 0; kb < 4; ++kb)
#pragma unroll
      for (int i = 0; i < 16; ++i) __builtin_nontemporal_store(S[kb][i], sp + (size_t)(kb * 32 + crow(i, g)) * 128);
  }
}

DI void hgrn_lat_pc(const Params& p_in, int l, int seq, int role, char* smem) {
  Params p = p_in; launder_params(p);
  const int tid = tidx(), lane = tid & 63, wave = tid >> 6, r = lane & 31, g = lane >> 5;
  const int dir = seq & 1, h = (seq >> 1) & 3, b = seq >> 3;
  const int T = 1024;
  const int rowbase = NCTX + b * 1024;
  constexpr int QROW = 272, EROW = 80;
  constexpr int BUFB = 2 * 32 * QROW + 2 * 128 * EROW + 1024;
  float* TOT = (float*)(smem + 2 * BUFB);
  const int kk = tid & 127, hf = tid >> 7;
  const int nchunk = T >> 5;
  const u16* pr = (const u16*)(p.ws + W_PROJ);
  if (role == 1) {
    const float lbk = ((const float*)(p.ws + W_LBV))[(l * 2 + dir) * 512 + h * 128 + kk];
    const int fcol = (dir ? C_HFB : C_HFF) + h * 128 + kk;
    const int qcol = C_HQ + h * 128 + kk;
    const int vcol = C_HI + h * 128 + kk;
    u16 rf[16], rq[16], rv[16];
#define HG_GLOAD(C)                                                                  \
  {                                                                                  \
    _Pragma("unroll") for (int i = 0; i < 16; ++i) {                                 \
      int sp_ = (C) * 32 + hf * 16 + i;                                              \
      int tok_ = dir ? (T - 1 - sp_) : sp_;                                          \
      const u16* rp_ = pr + (size_t)(rowbase + tok_) * PW;                           \
      rf[i] = rp_[fcol]; rq[i] = rp_[qcol]; rv[i] = rp_[vcol];                       \
    }                                                                                \
  }
    HG_GLOAD(0)
    for (int c = 0; c <= nchunk; ++c) {
      if (c < nchunk) {
        char* QT = smem + (c & 1) * BUFB;
        char* KT = QT + 32 * QROW;
        char* KE = KT + 32 * QROW;
        char* VT = KE + 128 * EROW;
        float* EMID = (float*)(VT + 128 * EROW);
        float* DEC = EMID + 128;
        float kv[16], ef[16], qv[16];
        unsigned vp[8];
        float run = 1.f;
#pragma unroll
        for (int i = 0; i < 16; ++i) {
          qv[i] = bf2f(rq[i]) * 0.08838834764831845f;
          if (i & 1) vp[i >> 1] |= ((unsigned)rv[i]) << 16; else vp[i >> 1] = (unsigned)rv[i];
        }
        if (hf) {
#pragma unroll
          for (int i = 0; i < 16; ++i) {
            const float f = lbk + (1.f - lbk) * sigmoidf_(bf2f(rf[i]));
            kv[i] = 1.f - f;
            run *= f; ef[i] = run;
          }
        } else {
#pragma unroll
          for (int i = 15; i >= 0; --i) {
            const float f = lbk + (1.f - lbk) * sigmoidf_(bf2f(rf[i]));
            kv[i] = 1.f - f;
            ef[i] = run; run *= f;
          }
        }
        TOT[hf * 128 + kk] = run;
        {
          const int cn = (c + 1 < nchunk) ? c + 1 : c;
          HG_GLOAD(cn)
        }
        __builtin_amdgcn_sched_barrier(0);
        __syncthreads();
        {
          const float F0 = TOT[kk], F1 = TOT[128 + kk];
          unsigned ke[8];
#pragma unroll
          for (int i = 0; i < 16; ++i) {
            const int tl = hf * 16 + i;
            const float inv = frcp(ef[i]);
            const float eq = hf ? ef[i] : inv;
            const float ek = hf ? inv : ef[i];
            const float ee = ek * F1;
            *(u16*)(QT + tl * QROW + kk * 2) = f2bf(qv[i] * eq);
            *(u16*)(KT + tl * QROW + kk * 2) = f2bf(kv[i] * ek);
            const float ken = kv[i] * ee;
            if (i & 1) ke[i >> 1] = pk2(__uint_as_float(ke[i >> 1]), ken);
            else ke[i >> 1] = __float_as_uint(ken);
          }
          *(uint4*)(KE + kk * EROW + hf * 32) = make_uint4(ke[0], ke[1], ke[2], ke[3]);
          *(uint4*)(KE + kk * EROW + hf * 32 + 16) = make_uint4(ke[4], ke[5], ke[6], ke[7]);
          *(uint4*)(VT + kk * EROW + hf * 32) = make_uint4(vp[0], vp[1], vp[2], vp[3]);
          *(uint4*)(VT + kk * EROW + hf * 32 + 16) = make_uint4(vp[4], vp[5], vp[6], vp[7]);
          if (hf == 0) { EMID[kk] = F0; DEC[kk] = F0 * F1; }
        }
        __syncthreads();
      } else {
        __syncthreads();
        __syncthreads();
      }
    }
#undef HG_GLOAD
  } else {
    f32x16 S[4];
    {
      const float* sp = p.state_hgrn + (((size_t)(b * 2 + l) * 2 + dir) * 4 + h) * 16384 + wave * 32 + r;
#pragma unroll
      for (int kb = 0; kb < 4; ++kb)
#pragma unroll
        for (int i = 0; i < 16; ++i) S[kb][i] = sp[(size_t)(kb * 32 + crow(i, g)) * 128];
    }
    u16* obase = dir ? (u16*)(p.ws + W_OB) : (u16*)(p.ws + W_BRANCH);
    const size_t ostride = dir ? 512 : 2048;
    __syncthreads();
    __syncthreads();
    for (int c = 0; c < nchunk; ++c) {
      char* QT = smem + (c & 1) * BUFB;
      char* KT = QT + 32 * QROW;
      char* KE = KT + 32 * QROW;
      char* VT = KE + 128 * EROW;
      float* EMID = (float*)(VT + 128 * EROW);
      float* DEC = EMID + 128;
      f32x16 oacc;
#pragma unroll
      for (int i = 0; i < 16; ++i) oacc[i] = 0.f;
#pragma unroll
      for (int kb = 0; kb < 4; ++kb) {
#pragma unroll
        for (int s = 0; s < 2; ++s) {
          const float4 e0 = *(const float4*)(EMID + kb * 32 + 16 * s + 4 * g);
          const float4 e1 = *(const float4*)(EMID + kb * 32 + 16 * s + 8 + 4 * g);
          uint4 au;
          au.x = pk2(S[kb][8 * s + 0] * e0.x, S[kb][8 * s + 1] * e0.y);
          au.y = pk2(S[kb][8 * s + 2] * e0.z, S[kb][8 * s + 3] * e0.w);
          au.z = pk2(S[kb][8 * s + 4] * e1.x, S[kb][8 * s + 5] * e1.y);
          au.w = pk2(S[kb][8 * s + 6] * e1.z, S[kb][8 * s + 7] * e1.w);
          const char* qp = QT + r * QROW + (kb * 32 + 16 * s + 4 * g) * 2;
          bf16x4 lo = *(const bf16x4*)(qp);
          bf16x4 hi = *(const bf16x4*)(qp + 16);
          oacc = MFMA32(__builtin_bit_cast(bf16x8, au), __builtin_shufflevector(lo, hi, 0, 1, 2, 3, 4, 5, 6, 7), oacc);
        }
      }
      f32x16 sacc;
#pragma unroll
      for (int i = 0; i < 16; ++i) sacc[i] = 0.f;
#pragma unroll
      for (int ks = 0; ks < 8; ++ks) {
        bf16x8 ka = *(const bf16x8*)(KT + r * QROW + (16 * ks + 8 * g) * 2);
        bf16x8 qb = *(const bf16x8*)(QT + r * QROW + (16 * ks + 8 * g) * 2);
        sacc = MFMA32(ka, qb, sacc);
      }
#pragma unroll
      for (int i = 0; i < 16; ++i) sacc[i] = (crow(i, g) <= r) ? sacc[i] : 0.f;
      __syncthreads();
#pragma unroll
      for (int s2 = 0; s2 < 2; ++s2) {
        uint4 pu;
        pu.x = pk2(sacc[8 * s2 + 0], sacc[8 * s2 + 1]); pu.y = pk2(sacc[8 * s2 + 2], sacc[8 * s2 + 3]);
        pu.z = pk2(sacc[8 * s2 + 4], sacc[8 * s2 + 5]); pu.w = pk2(sacc[8 * s2 + 6], sacc[8 * s2 + 7]);
        const char* vq = VT + (wave * 32 + r) * EROW + (16 * s2 + 4 * g) * 2;
        bf16x4 lo = *(const bf16x4*)(vq);
        bf16x4 hi = *(const bf16x4*)(vq + 16);
        oacc = MFMA32(__builtin_shufflevector(lo, hi, 0, 1, 2, 3, 4, 5, 6, 7), __builtin_bit_cast(bf16x8, pu), oacc);
      }
      {
        int sp_ = c * 32 + r;
        int tok_ = dir ? (T - 1 - sp_) : sp_;
        u16* op = obase + (size_t)(rowbase + tok_) * ostride + h * 128 + wave * 32 + 4 * g;
#pragma unroll
        for (int q4 = 0; q4 < 4; ++q4)
          *(uint2*)(op + 8 * q4) = pk4(oacc[4 * q4 + 0], oacc[4 * q4 + 1], oacc[4 * q4 + 2], oacc[4 * q4 + 3]);
      }
#pragma unroll
      for (int kb = 0; kb < 4; ++kb) {
#pragma unroll
        for (int q4 = 0; q4 < 4; ++q4) {
          const float4 d4 = *(const float4*)(DEC + kb * 32 + 8 * q4 + 4 * g);
          S[kb][4 * q4 + 0] *= d4.x; S[kb][4 * q4 + 1] *= d4.y; S[kb][4 * q4 + 2] *= d4.z; S[kb][4 * q4 + 3] *= d4.w;
        }
#pragma unroll
        for (int s = 0; s < 2; ++s) {
          bf16x8 ka = *(const bf16x8*)(KE + (kb * 32 + r) * EROW + (16 * s + 8 * g) * 2);
          bf16x8 vb = *(const bf16x8*)(VT + (wave * 32 + r) * EROW + (16 * s + 8 * g) * 2);
          S[kb] = MFMA32(ka, vb, S[kb]);
        }
      }
      __syncthreads();
    }
  }
}

DI void hgpost_job(const Params& p_in, int l, int job) {
  Params p = p_in; launder_params(p);
  const int tid = tidx(), li = tid & 31;
  const float4 gn = *(const float4*)(p.hg_gain + l * 128 + li * 4);
  const u16* pr = (const u16*)(p.ws + W_PROJ);
  u16* br = (u16*)(p.ws + W_BRANCH);
  const u16* ob = (const u16*)(p.ws + W_OB);
  for (int pass = 0; pass < 16; ++pass) {
    int vec = pass * 8 + (tid >> 5);
    int row = job * 32 + (vec >> 2), h = vec & 3;
    float a[4], bb[4], gt[4];
    unpack4(*(const uint2*)(br + (size_t)row * 2048 + h * 128 + li * 4), a);
    unpack4(*(const uint2*)(ob + (size_t)row * 512 + h * 128 + li * 4), bb);
    unpack4(*(const uint2*)(pr + (size_t)row * PW + C_HG + h * 128 + li * 4), gt);
    float o0 = a[0] + bb[0], o1 = a[1] + bb[1], o2 = a[2] + bb[2], o3 = a[3] + bb[3];
    float ss = o0 * o0 + o1 * o1 + o2 * o2 + o3 * o3;
#pragma unroll
    for (int o = 16; o >= 1; o >>= 1) ss += shx(ss, o);
    float rstd = rsqrtf(ss * (1.f / 128.f) + EPS);
    *(uint2*)(br + (size_t)row * 2048 + h * 128 + li * 4) =
        pk4(o0 * rstd * gn.x * siluf_(gt[0]), o1 * rstd * gn.y * siluf_(gt[1]), o2 * rstd * gn.z * siluf_(gt[2]),
            o3 * rstd * gn.w * siluf_(gt[3]));
  }
}

DI void inproj_tile(const Params& p_in, int idx, char* smem) {
  Params p = p_in; launder_params(p);
  const int mt = idx & 63, nt = idx >> 6;
  f32x16 acc[2][2];
  zero_acc<2, 2>(acc);
  gemm_core<2, 2>((const u16*)(p.ws + W_H) + (size_t)mt * 128 * 1024, 1024, (const u16*)(p.ws + W_IN) + (size_t)nt * 128 * 1024, 1024,
                  PW - nt * 128, 1024, acc, smem);
  u16* pr = (u16*)(p.ws + W_PROJ);
  EPI_LOOP(2, 2, acc, {
    int col = nt * 128 + ec;
    if (col < PW) {
      size_t o = (size_t)(mt * 128 + er) * PW + col;
      pr[o] = f2bf(v0); pr[o + PW] = f2bf(v1); pr[o + 2 * PW] = f2bf(v2); pr[o + 3 * PW] = f2bf(v3);
    }
  })
}

DI void qb_tile(const Params& p_in, int l, int idx, char* smem) {
  Params p = p_in; launder_params(p);
  const size_t wo = l ? W_SET2 : 0;
  const int mt = idx & 63, nt = idx >> 6;
  f32x16 acc[2][2];
  zero_acc<2, 2>(acc);
  gemm_core<2, 2>((const u16*)(p.ws + W_AQ) + (size_t)mt * 128 * 256, 256, (const u16*)(p.ws + wo + W_QB) + (size_t)nt * 128 * 256, 256, 128, 256,
                  acc, smem);
  u16* qd = (u16*)(p.ws + W_QD);
  EPI_LOOP(2, 2, acc, {
    size_t o = (size_t)(mt * 128 + er) * 768 + nt * 128 + ec;
    qd[o] = f2bf(v0); qd[o + 768] = f2bf(v1); qd[o + 2 * 768] = f2bf(v2); qd[o + 3 * 768] = f2bf(v3);
  })
}

DI void kvb_tile(const Params& p_in, int l, int idx, char* smem) {
  Params p = p_in; launder_params(p);
  const size_t wo = l ? W_SET2 : 0;
  const int mt = idx % 80, h = idx / 80;
  f32x16 acc[2][2];
  zero_acc<2, 2>(acc);
  gemm_core<2, 2>((const u16*)(p.ws + W_ACKV) + (size_t)mt * 128 * 128, 128, (const u16*)(p.ws + wo + W_KVB) + (size_t)h * 128 * 128, 128, 128, 128,
                  acc, smem);
  const int r0 = mt * 128;
  u16* kd; u16* vt; size_t vstride; int key0;
  if (r0 < NCTX) {
    int b = r0 >> 8; key0 = r0 & 255;
    kd = (u16*)(p.ws + W_KDC) + (size_t)r0 * 768;
    vt = (u16*)(p.ws + W_VDTC) + (size_t)b * 512 * 256; vstride = 256;
  } else if (r0 < NTOK) {
    int rr = r0 - NCTX; int b = rr >> 10; key0 = 512 + (rr & 1023);
    kd = (u16*)(p.ws + W_KDL) + ((size_t)b * 1536 + key0) * 768;
    vt = (u16*)(p.ws + W_VDTL) + (size_t)b * 512 * 1536; vstride = 1536;
  } else {
    int rr = r0 - NTOK; int b = rr >> 9; key0 = rr & 511;
    kd = (u16*)(p.ws + W_KDL) + ((size_t)b * 1536 + key0) * 768;
    vt = (u16*)(p.ws + W_VDTL) + (size_t)b * 512 * 1536; vstride = 1536;
  }
  EPI_LOOP(2, 2, acc, {
    if (ec < 64) {
      size_t o = (size_t)er * 768 + h * 96 + ec;
      kd[o] = f2bf(v0); kd[o + 768] = f2bf(v1); kd[o + 2 * 768] = f2bf(v2); kd[o + 3 * 768] = f2bf(v3);
    } else {
      *(uint2*)(vt + (size_t)(h * 64 + ec - 64) * vstride + key0 + er) = pk4(v0, v1, v2, v3);
    }
  })
}

DI void merge_tile(const Params& p_in, int idx, char* smem) {
  Params p = p_in; launder_params(p);
  const int mt = idx & 63, nt = idx >> 6;
  f32x16 tot[2][1], bo[2][1], gg[2][1];
  zero_acc<2, 1>(tot);
#pragma unroll 1
  for (int n = 0; n < 4; ++n) {
    zero_acc<2, 1>(bo);
    zero_acc<2, 1>(gg);
    gemm_core<2, 1>((const u16*)(p.ws + W_BRANCH) + (size_t)mt * 128 * 2048 + n * 512, 2048,
                    (const u16*)(p.ws + W_BR) + ((size_t)n * 1024 + nt * 64) * 512, 512, 64, 512, bo, smem);
    gemm_core<2, 1>((const u16*)(p.ws + W_H) + (size_t)mt * 128 * 1024, 1024,
                    (const u16*)(p.ws + W_IN) + ((size_t)C_GATES + n * 1024 + nt * 64) * 1024, 1024, 64, 1024, gg, smem);
#pragma unroll
    for (int mb = 0; mb < 2; ++mb)
#pragma unroll
      for (int i = 0; i < 16; ++i) tot[mb][0][i] += sigmoidf_(gg[mb][0][i]) * bo[mb][0][i];
  }
  u16* mg = (u16*)(p.ws + W_MERGED);
  EPI_LOOP(2, 1, tot, {
    size_t o = (size_t)(mt * 128 + er) * 1024 + nt * 64 + ec;
    mg[o] = f2bf(v0); mg[o + 1024] = f2bf(v1); mg[o + 2048] = f2bf(v2); mg[o + 3072] = f2bf(v3);
  })
}

DI void resid_tile(const Params& p_in, int l, int idx, const u16* A, int lda, const u16* Wt, int K, int which, char* smem) {
  Params p = p_in; launder_params(p);
  const int mt = idx & 63, nt = idx >> 6;
  f32x16 acc[2][2];
  zero_acc<2, 2>(acc);
  gemm_core<2, 2>(A + (size_t)mt * 128 * lda, lda, Wt + (size_t)nt * 128 * K, K, 128, K, acc, smem);
  const int cond = cond_of_row(mt * 128);
  const float* gt = (const float*)(p.ws + W_MOD) + (size_t)(l * 5 + cond) * 6144 + which * 1024;
  EPI_LOOP(2, 2, acc, {
    int col = nt * 128 + ec;
    float gv = gt[col];
    float* xp = p.out + (size_t)(mt * 128 + er) * 1024 + col;
    xp[0] += gv * v0; xp[1024] += gv * v1; xp[2048] += gv * v2; xp[3072] += gv * v3;
  })
}

DI void ffn1_tile(const Params& p_in, int idx, char* smem) {
  Params p = p_in; launder_params(p);
  const int mt = idx & 63, nt = idx >> 6;
  f32x16 acc[2][2];
  zero_acc<2, 2>(acc);
  gemm_core<2, 2>((const u16*)(p.ws + W_H) + (size_t)mt * 128 * 1024, 1024, (const u16*)(p.ws + W_FFI) + (size_t)nt * 128 * 1024, 1024, 128, 1024,
                  acc, smem);
  u16* hd = (u16*)(p.ws + W_HIDDEN);
  const int lane = tidx() & 63, wave = tidx() >> 6, wm = wave >> 1, wn = wave & 1, g = lane >> 5;
#pragma unroll
  for (int mb = 0; mb < 2; ++mb)
#pragma unroll
    for (int i = 0; i < 16; ++i) {
      float av = acc[mb][0][i], gv = acc[mb][1][i];
      int row = mt * 128 + wm * 64 + mb * 32 + crow(i, g);
      int col = (nt * 2 + wn) * 32 + (lane & 31);
      hd[(size_t)row * FFH + col] = f2bf(siluf_(gv) * av);
    }
}


DI void inproj_phase512(const Params& p_in, int l, int bid, int G, char* smem) {
  Params p = p_in; launder_params(p);
  const size_t wo = l ? W_SET2 : 0;
  u32x4 ra[4], rb[4];
  bool pre = false;
  for (int idx = bid; idx < 32 * 21; idx += G) {
    const int mt = idx & 31, nt = idx >> 5;
    const int idn = idx + G;
    const bool has_next = idn < 32 * 21;
    const int mtn = has_next ? (idn & 31) : mt, ntn = has_next ? (idn >> 5) : nt;
    const GDesc512<4> c = make_gdesc<4>((const u16*)(p.ws + W_H) + (size_t)mt * 256 * 1024, 1024,
                                        (const u16*)(p.ws + wo + W_IN) + (size_t)nt * 256 * 1024, 1024, PW - nt * 256, 1024);
    const GDesc512<4> n = make_gdesc<4>((const u16*)(p.ws + W_H) + (size_t)mtn * 256 * 1024, 1024,
                                        (const u16*)(p.ws + wo + W_IN) + (size_t)ntn * 256 * 1024, 1024, PW - ntn * 256, 1024);
    f32x16 acc[2][4];
    zero_acc<2, 4>(acc);
    gemm512_chain<2, 4>(c, n, has_next, pre, ra, rb, acc, smem);
    pre = has_next;
    u16* pr = (u16*)(p.ws + W_PROJ);
    EPI512(2, 4, acc, {
      int col = nt * 256 + ec;
      if (col < PW) {
        size_t o = (size_t)(mt * 256 + er) * PW + col;
        pr[o] = f2bf(v0); pr[o + PW] = f2bf(v1); pr[o + 2 * PW] = f2bf(v2); pr[o + 3 * PW] = f2bf(v3);
      }
    })
  }
}

DI void ffn1_phase512(const Params& p_in, int l, int bid, int G, char* smem) {
  Params p = p_in; launder_params(p);
  const size_t wo = l ? W_SET2 : 0;
  u32x4 ra[4], rb[4];
  bool pre = false;
  for (int idx = bid; idx < 32 * 22; idx += G) {
    const int mt = idx & 31, nt = idx >> 5;
    const int idn = idx + G;
    const bool has_next = idn < 32 * 22;
    const int mtn = has_next ? (idn & 31) : mt, ntn = has_next ? (idn >> 5) : nt;
    const GDesc512<4> c = make_gdesc<4>((const u16*)(p.ws + W_H) + (size_t)mt * 256 * 1024, 1024,
                                        (const u16*)(p.ws + wo + W_FFI) + (size_t)nt * 256 * 1024, 1024, 256, 1024);
    const GDesc512<4> n = make_gdesc<4>((const u16*)(p.ws + W_H) + (size_t)mtn * 256 * 1024, 1024,
                                        (const u16*)(p.ws + wo + W_FFI) + (size_t)ntn * 256 * 1024, 1024, 256, 1024);
    f32x16 acc[2][4];
    zero_acc<2, 4>(acc);
    gemm512_chain<2, 4>(c, n, has_next, pre, ra, rb, acc, smem);
    pre = has_next;
    u16* hd = (u16*)(p.ws + W_HIDDEN);
    const int t5 = tidx512();
    const int lane = t5 & 63, wave = t5 >> 6, wm = wave >> 1, wn = wave & 1, g = lane >> 5;
#pragma unroll
    for (int mb = 0; mb < 2; ++mb)
#pragma unroll
      for (int pr2 = 0; pr2 < 2; ++pr2)
#pragma unroll
        for (int i = 0; i < 16; ++i) {
          float av = acc[mb][2 * pr2][i], gv = acc[mb][2 * pr2 + 1][i];
          int row = mt * 256 + wm * 64 + mb * 32 + crow(i, g);
          int col = (nt * 4 + wn * 2 + pr2) * 32 + (lane & 31);
          hd[(size_t)row * FFH + col] = f2bf(siluf_(gv) * av);
        }
  }
}

DI void resid512(const Params& p_in, int l, int idx, const u16* A, int lda, const u16* Wt, int K, int which, char* smem) {
  Params p = p_in; launder_params(p);
  const int mt = idx & 31, nt = idx >> 5;
  f32x16 acc[2][2];
  zero_acc<2, 2>(acc);
  gemm512_core<2, 2>(A + (size_t)mt * 256 * lda, lda, Wt + (size_t)nt * 128 * K, K, 128, K, acc, smem);
  const int cond = cond_of_row(mt * 256);
  const float* gt = (const float*)(p.ws + W_MOD) + (size_t)(l * 5 + cond) * 6144 + which * 1024;
  EPI512(2, 2, acc, {
    int col = nt * 128 + ec;
    float gv = gt[col];
    float* xp = p.out + (size_t)(mt * 256 + er) * 1024 + col;
    xp[0] += gv * v0; xp[1024] += gv * v1; xp[2048] += gv * v2; xp[3072] += gv * v3;
  })
}

DI void merge512(const Params& p_in, int l, int idx, char* smem) {
  Params p = p_in; launder_params(p);
  const size_t wo = l ? W_SET2 : 0;
  const int mt = idx & 31, nt = idx >> 5;
  unsigned totp[2][2][8], sgp[2][2][8];
#pragma unroll
  for (int mb = 0; mb < 2; ++mb)
#pragma unroll
    for (int nb = 0; nb < 2; ++nb)
#pragma unroll
      for (int i = 0; i < 8; ++i) totp[mb][nb][i] = 0u;
  u32x4 ra[4], rb[2];
  const u16* Hrow = (const u16*)(p.ws + W_H) + (size_t)mt * 256 * 1024;
  const u16* Brow = (const u16*)(p.ws + W_BRANCH) + (size_t)mt * 256 * 2048;
  const u16* Wg = (const u16*)(p.ws + wo + W_IN) + ((size_t)C_GATES + nt * 128) * 1024;
  const u16* Wb = (const u16*)(p.ws + wo + W_BR) + (size_t)(nt * 128) * 512;
#pragma unroll 1
  for (int n = 0; n < 4; ++n) {
    const GDesc512<2> dg = make_gdesc<2>(Hrow, 1024, Wg + (size_t)n * 1024 * 1024, 1024, 128, 1024);
    const GDesc512<2> db = make_gdesc<2>(Brow + n * 512, 2048, Wb + (size_t)n * 1024 * 512, 512, 128, 512);
    const int n1 = n < 3 ? n + 1 : n;
    const GDesc512<2> dg1 = make_gdesc<2>(Hrow, 1024, Wg + (size_t)n1 * 1024 * 1024, 1024, 128, 1024);
    {
      f32x16 gg[2][2];
      zero_acc<2, 2>(gg);
      gemm512_chain<2, 2>(dg, db, true, n > 0, ra, rb, gg, smem);
#pragma unroll
      for (int mb = 0; mb < 2; ++mb)
#pragma unroll
        for (int nb = 0; nb < 2; ++nb)
#pragma unroll
          for (int i = 0; i < 8; ++i) sgp[mb][nb][i] = pk2(sigmoidf_(gg[mb][nb][2 * i]), sigmoidf_(gg[mb][nb][2 * i + 1]));
    }
    {
      f32x16 bo[2][2];
      zero_acc<2, 2>(bo);
      gemm512_chain<2, 2>(db, dg1, n < 3, true, ra, rb, bo, smem);
#pragma unroll
      for (int mb = 0; mb < 2; ++mb)
#pragma unroll
        for (int nb = 0; nb < 2; ++nb)
#pragma unroll
          for (int i = 0; i < 8; ++i) {
            const unsigned t = totp[mb][nb][i], g2 = sgp[mb][nb][i];
            const float lo = __uint_as_float(t << 16) + __uint_as_float(g2 << 16) * bo[mb][nb][2 * i];
            const float hi = __uint_as_float(t & 0xffff0000u) + __uint_as_float(g2 & 0xffff0000u) * bo[mb][nb][2 * i + 1];
            totp[mb][nb][i] = pk2(lo, hi);
          }
    }
  }
  u16* mg = (u16*)(p.ws + W_MERGED);
  {
    const int t5 = tidx512();
    const int lane = t5 & 63, wave = t5 >> 6, wm = wave >> 1, wn = wave & 1, g = lane >> 5;
#pragma unroll
    for (int mb = 0; mb < 2; ++mb)
#pragma unroll
      for (int nb = 0; nb < 2; ++nb)
#pragma unroll
        for (int i = 0; i < 8; ++i) {
          const int row = mt * 256 + wm * 64 + mb * 32 + crow(2 * i, g);
          const int col = nt * 128 + wn * 64 + nb * 32 + (lane & 31);
          const unsigned t = totp[mb][nb][i];
          mg[(size_t)row * 1024 + col] = (u16)(t & 0xffffu);
          mg[(size_t)(row + 1) * 1024 + col] = (u16)(t >> 16);
        }
  }
}


constexpr int NWCONV = 16 * 37 + 16 * 22 + 44 * 4 + 4 * 8 * 4 + 16 * 4 + 4 * 3 + 2 * 4;
DI void wconv_job(const Params& p_in, int l, int j, char* sm) {
  Params p = p_in; launder_params(p);
  char* wb = p.ws + (l ? W_SET2 : 0);
  const int e0 = 16 * 37, e1 = e0 + 16 * 22, e2 = e1 + 44 * 4, e3 = e2 + 4 * 8 * 4, e4 = e3 + 16 * 4, e5 = e4 + 4 * 3;
  if (j < e0) {
    wtrans_tile(p.w_in + (size_t)l * 1024 * INW, 1024, INW, j / 37, j % 37, (u16*)(wb + W_IN), false, sm);
  } else if (j < e1) {
    int t = j - e0;
    wtrans_tile(p.w_ffn_in + (size_t)l * 1024 * 5632, 1024, 5632, t / 22, t % 22, (u16*)(wb + W_FFI), true, sm);
  } else if (j < e2) {
    int t = j - e1;
    wtrans_tile(p.w_ffn_out + (size_t)l * FFH * 1024, FFH, 1024, t >> 2, t & 3, (u16*)(wb + W_FFO), false, sm);
  } else if (j < e3) {
    int t = j - e2;
    int n = t >> 5, tt = t & 31;
    wtrans_tile(p.w_branch + ((size_t)l * 4 + n) * 512 * 1024, 512, 1024, tt >> 2, tt & 3, (u16*)(wb + W_BR) + (size_t)n * 1024 * 512, false, sm);
  } else if (j < e4) {
    int t = j - e3;
    wtrans_tile(p.w_out + (size_t)l * 1024 * 1024, 1024, 1024, t >> 2, t & 3, (u16*)(wb + W_OUT), false, sm);
  } else if (j < e5) {
    int t = j - e4;
    wtrans_tile(p.ml_w_q_b + (size_t)l * 256 * 768, 256, 768, t / 3, t % 3, (u16*)(wb + W_QB), false, sm);
  } else {
    int t = j - e5;
    wtrans_tile(p.ml_w_kv_b + (size_t)l * 128 * 1024, 128, 1024, t >> 2, t & 3, (u16*)(wb + W_KVB), false, sm);
  }
}

#define XB_TMO      128
#define XB_XCNT(j)  (256  + 64 * (j))
#define XB_XSUB(j)  (1280 + 64 * (j))
#define XB_XGEN(j)  (2304 + 64 * (j))
#define XB_TOP      3328
#define XB_TOPGEN   3392
#define XCD_BAR_WORDS 3456
#define XB_SPIN_CAP (1u << 18)
#define LAS __attribute__((address_space(3)))
DI unsigned xb_ld(unsigned* p) { return __hip_atomic_load(p, __ATOMIC_RELAXED, __HIP_MEMORY_SCOPE_AGENT); }
DI unsigned xb_add(unsigned* p, unsigned v) { return __hip_atomic_fetch_add(p, v, __ATOMIC_RELAXED, __HIP_MEMORY_SCOPE_AGENT); }
DI unsigned xb_xcc_id() { return (unsigned)__builtin_amdgcn_s_getreg((3 << 11) | 20) & 0xFu; }
#define XB_SPIN(cond, bar) do { unsigned _sp = 0; while (cond) { __builtin_amdgcn_s_sleep(1); \
    if ((++_sp & 255u) == 0u) { if (xb_ld(&(bar)[XB_TMO])) break; if (_sp > XB_SPIN_CAP) { atomicAdd(&(bar)[XB_TMO], 1u); break; } } } } while (0)
struct XcdBarrier { unsigned* bar; unsigned x; volatile LAS unsigned* st; };
DI XcdBarrier xcd_barrier_post(unsigned* bar, volatile LAS unsigned* st) {
  XcdBarrier b; b.bar = bar; b.x = xb_xcc_id(); b.st = st;
  if (threadIdx.x == 0) (void)xb_add(&bar[XB_XCNT(b.x)], 1u);
  return b;
}
DI void xcd_barrier_complete(unsigned* bar, unsigned x, unsigned& nloc, unsigned& nx) {
  const unsigned G = gridDim.x * gridDim.y * gridDim.z;
  unsigned sum, cnt, mine, sp = 0u;
  for (;;) {
    sum = 0u; cnt = 0u; mine = 0u;
#pragma unroll
    for (unsigned j = 0; j < 16; ++j) { const unsigned c = xb_ld(&bar[XB_XCNT(j)]); sum += c; cnt += (c > 0u) ? 1u : 0u; mine = (j == x) ? c : mine; }
    if (sum == G) break;
    __builtin_amdgcn_s_sleep(1);
    if ((++sp & 255u) == 0u) { if (xb_ld(&bar[XB_TMO])) break; if (sp > XB_SPIN_CAP) { atomicAdd(&bar[XB_TMO], 1u); break; } }
  }
  nloc = mine > 0u ? mine : 1u; nx = cnt > 0u ? cnt : 1u;
}
DI void xcd_barrier(const XcdBarrier& b) {
  asm volatile("s_waitcnt vmcnt(0)" ::: "memory");
  __syncthreads();
  if (threadIdx.x == 0) {
    unsigned* bar = b.bar;
    __builtin_amdgcn_s_waitcnt(0);
    unsigned nloc = b.st[0], nx = b.st[1];
    if (nloc == 0u) { xcd_barrier_complete(bar, b.x, nloc, nx); b.st[0] = nloc; b.st[1] = nx; }
    const unsigned old = xb_add(&bar[XB_XSUB(b.x)], 1u);
    const unsigned gen = old / nloc;
    if (old + 1u == (gen + 1u) * nloc) {
      __builtin_amdgcn_fence(__ATOMIC_RELEASE, "agent");
      asm volatile("s_waitcnt vmcnt(0)" ::: "memory");
      const unsigned og = xb_add(&bar[XB_TOP], 1u);
      const unsigned tg = og / nx;
      if (og + 1u == (tg + 1u) * nx) xb_add(&bar[XB_TOPGEN], 1u);
      else XB_SPIN(xb_ld(&bar[XB_TOPGEN]) == tg, bar);
      __builtin_amdgcn_fence(__ATOMIC_ACQUIRE, "agent");
      xb_add(&bar[XB_XGEN(b.x)], 1u);
      asm volatile("s_waitcnt vmcnt(0)" ::: "memory");
    } else {
      XB_SPIN(xb_ld(&bar[XB_XGEN(b.x)]) == gen, bar);
      __builtin_amdgcn_fence(__ATOMIC_ACQUIRE, "agent");
      asm volatile("s_waitcnt vmcnt(0)" ::: "memory");
    }
  }
  __syncthreads();
}


DI int launder_s(int x) { asm volatile("" : "+s"(x)); return x; }
#define SMH (smem + launder_s(sub) * SMEM_HALF)
#define WFILL2(ci, LAYER, lo1, n1, lo2, n2)                                      \
  {                                                                              \
    int* fctr_ = (int*)(p.ws + W_CTR) + (ci);                                    \
    for (;;) {                                                                   \
      if (threadIdx.x == 0) s_next = atomicAdd(fctr_, 2);                        \
      __syncthreads();                                                           \
      const int ff_ = s_next + sub;                                              \
      __syncthreads();                                                           \
      if (ff_ >= (n1) + (n2)) break;                                             \
      wconv_job(p, (LAYER), ff_ < (n1) ? (lo1) + ff_ : (lo2) + (ff_ - (n1)), SMH); \
    }                                                                            \
  }

__global__ void __launch_bounds__(512, 2) fwd_megakernel(Params p) {
  cg::grid_group grid = cg::this_grid();
  __shared__ __attribute__((aligned(16))) char smem[SMEM_BYTES];
  __shared__ int s_next;
  __shared__ uint4 xb_words;
  const int G = gridDim.x, bid = blockIdx.x;
  const int sub = __builtin_amdgcn_readfirstlane((int)(threadIdx.x >> 8));
  if (threadIdx.x == 0) xb_words = make_uint4(0u, 0u, 0u, 0u);
  __syncthreads();
  const XcdBarrier xb = xcd_barrier_post((unsigned*)(p.ws + W_BAR), (volatile LAS unsigned*)&xb_words);

  for (int l = 0; l < 2; ++l) {
    if (l == 0) {
      const int q0 = 192, q1 = q0 + 64, q2 = q1 + 612, q3 = q2 + 18;
      int* ctr = (int*)(p.ws + W_CTR) + 14;
      for (;;) {
        if (threadIdx.x == 0) s_next = atomicAdd(ctr, 2);
        __syncthreads();
        const int j = s_next + sub;
        __syncthreads();
        if (j >= q3) break;
        if (j < q0) adaln_job(p, j / 96, j % 96, SMH);
        else if (j < q1) cache_job(p, 0, j - q0, SMH);
        else if (j < q2) { const int t = j - q1; wconv_job(p, 0, t < 592 ? t : 1312 + (t - 592), SMH); }
        else misc_job(p, j - q2);
      }
    } else {
      for (int j0 = bid * 2; j0 < 64 + 2048; j0 += 2 * G) {
        const int j = j0 + sub;
        if (j < 64) cache_job(p, 1, j, SMH);
        else norm_job(p, 1, 0, j - 64, false);
      }
    }
    if (p.ws == nullptr) grid.sync();
    xcd_barrier(xb);
    if (l == 0) {
      for (int j0 = bid * 2; j0 < 2048; j0 += 2 * G) norm_job(p, 0, 0, j0 + sub, true);
      xcd_barrier(xb);
    }
    inproj_phase512(p, l, bid, G, smem);
    if (l == 0) WFILL2(4, 0, 1120, 192, 592, 148)
    else        WFILL2(5, 1, 1120, 192, 592, 148)
    xcd_barrier(xb);
    for (int j0 = bid * 2; j0 < 512; j0 += 2 * G) prep_job(p, l, ((j0 >> 2) << 1) + sub, (j0 >> 1) & 1, SMH);
    xcd_barrier(xb);
    {
      const int a0 = 64, a1 = a0 + 256, a2 = a1 + 256, a3 = a2 + 128, a4 = a3 + 640, a5 = a4 + 384, a6 = a5 + 0, a7 = a6 + 0;
      int* ctr = (int*)(p.ws + W_CTR) + l * 2;
      for (;;) {
        if (threadIdx.x == 0) s_next = atomicAdd(ctr, 2);
        __syncthreads();
        const int j = s_next + sub;
        __syncthreads();
        if (j >= a7) break;
        if (j < a0) hgrn_lat_pc(p, l, j >> 1, sub, smem);
        else if (j < a1) gqa_item(p, 1, j - a0, SMH);
        else if (j < a2) na_lat_item(p, l, j - a1, SMH);
        else if (j < a3) hgrn_mfma_item(p, l, 0, j - a2, SMH);
        else if (j < a4) kvb_tile(p, l, j - a3, SMH);
        else if (j < a5) qb_tile(p, l, j - a4, SMH);
        else if (j < a6) gqa_item(p, 0, j - a5, SMH);
        else na_ctx_item(p, j - a6, SMH);
      }
      if (l == 0) WFILL2(6, 0, 740, 204, 0, 0)
      if (l == 0) WFILL2(7, 1, 164, 216, 0, 0)
    }
    xcd_barrier(xb);
    {
      int* ctr = (int*)(p.ws + W_CTR) + l * 2 + 1;
      for (;;) {
        if (threadIdx.x == 0) s_next = atomicAdd(ctr, 2);
        __syncthreads();
        const int j = s_next + sub;
        __syncthreads();
        if (j >= 1280) break;
        if (j < 256) mla_item(p, 1, j, SMH);
        else if (j < 512) hgpost_job(p, l, j - 256);
        else if (j < 768) mla_item(p, 0, j - 512, SMH);
        else if (j < 1024) gqa_item(p, 0, j - 768, SMH);
        else na_ctx_item(p, j - 1024, SMH);
      }
      if (l == 0) WFILL2(9, 0, 944, 176, 0, 0)
      if (l == 0) WFILL2(10, 1, 0, 164, 0, 0)
      if (l == 1) WFILL2(11, 1, 740, 204, 0, 0)
    }
    xcd_barrier(xb);
    for (int j = bid; j < 256; j += G) merge512(p, l, j, smem);
    xcd_barrier(xb);
    for (int j = bid; j < 256; j += G)
      resid512(p, l, j, (const u16*)(p.ws + W_MERGED), 1024, (const u16*)(p.ws + (l ? W_SET2 : 0) + W_OUT), 1024, 2, smem);
    xcd_barrier(xb);
    for (int j0 = bid * 2; j0 < 2048; j0 += 2 * G) norm_job(p, l, 1, j0 + sub, false);
    xcd_barrier(xb);
    ffn1_phase512(p, l, bid, G, smem);
    if (l == 0) WFILL2(12, 1, 380, 212, 1312, 20)
    else        WFILL2(8, 1, 944, 176, 0, 0)
    xcd_barrier(xb);
    for (int j = bid; j < 256; j += G)
      resid512(p, l, j, (const u16*)(p.ws + W_HIDDEN), FFH, (const u16*)(p.ws + (l ? W_SET2 : 0) + W_FFO), FFH, 5, smem);
    xcd_barrier(xb);
  }
  for (int j0 = bid * 2; j0 < 2048; j0 += 2 * G) final_norm_job(p, j0 + sub);
}

extern "C" void kernel_launch(void* const* d_in, const int* in_sizes, int n_in, void* d_out, int out_size, void* d_ws,
                              size_t ws_size, hipStream_t stream) {
  static int grid_blocks = 0;
  if (!grid_blocks) {
    int dev = 0, cus = 0, per_cu = 0;
    hipGetDevice(&dev);
    hipDeviceGetAttribute(&cus, hipDeviceAttributeMultiprocessorCount, dev);
    hipOccupancyMaxActiveBlocksPerMultiprocessor(&per_cu, fwd_megakernel, 512, 0);
    per_cu = 1;
    grid_blocks = cus * per_cu;
  }
  if (ws_size < W_TOTAL) { fprintf(stderr, "workspace too small: %zu < %zu\n", ws_size, (size_t)W_END); return; }
  Params p{};
  const float** f = (const float**)&p;
  for (int i = 0; i < 28; ++i) f[i] = (const float*)d_in[i];
  p.out = (float*)d_out;
  p.ws = (char*)d_ws;
  hipMemsetAsync((char*)d_ws + W_CTR, 0, 64 + 3456 * 4, stream);
  void* args[] = {&p};
  hipError_t e = hipLaunchCooperativeKernel((void*)fwd_megakernel, dim3(grid_blocks), dim3(512), args, 0, stream);
  if (e != hipSuccess) fprintf(stderr, "cooperative launch failed: %s (grid %d)\n", hipGetErrorString(e), grid_blocks);
}
```
